# Optimizing an MI355X kernel written in HIP

```python
import math
import jax, jax.numpy as jnp
from jax import lax
import numpy as np

D_MODEL = 1024
BATCH = 8
SEQ = 2048
DEPTH = 4

GRID_W = 64
MIX_WIDTH = 2 * D_MODEL
HG_WIDTH = MIX_WIDTH // 2
HG_HEAD_DIM = 128
HG_HEADS = HG_WIDTH // HG_HEAD_DIM
HG_CHUNK = 32
NA_WIDTH = MIX_WIDTH - HG_WIDTH
NA_HEAD_DIM = 64
NA_HEADS = NA_WIDTH // NA_HEAD_DIM
NA_ROWS_MAX = 8
NA_KC = 16
NA_SPAN = 2 * NA_KC
IN_COLS = 5 * HG_WIDTH + 4 * NA_WIDTH
ADA_COLS = 3 * D_MODEL
DEEPNORM_ALPHA = (2 * DEPTH) ** 0.25
DEEPNORM_BETA = (8 * DEPTH) ** -0.25
LN_EPS = 1e-5
RMS_EPS = 1e-6

kernel_name = "hymba_hgrn2_natten_deepnorm_encoder"


def _layernorm(x):
    xf = x.astype(jnp.float32)
    mu = jnp.mean(xf, axis=-1, keepdims=True)
    var = jnp.mean(jnp.square(xf - mu), axis=-1, keepdims=True)
    return (xf - mu) * lax.rsqrt(var + LN_EPS)


def _rmsnorm(x, g):
    xf = x.astype(jnp.float32)
    return xf * lax.rsqrt(jnp.mean(jnp.square(xf), axis=-1, keepdims=True) + RMS_EPS) * g.astype(jnp.float32)


def _hgrn2_lower_bounds(lb_logits):
    p = jax.nn.softmax(lb_logits.astype(jnp.float32), axis=0)
    cs = jnp.cumsum(p, axis=0)
    return cs - cs[0:1]


def _hgrn2_chunk_scan(q, k, v, log_f):
    B, H, S, DK = q.shape
    DV = v.shape[-1]
    C = HG_CHUNK
    N = S // C
    q, k, log_f = (t.reshape(B, H, N, C, DK) for t in (q, k, log_f))
    v = v.reshape(B, H, N, C, DV)
    b = jnp.cumsum(log_f, axis=3)
    b_mid = b[:, :, :, C // 2 - 1:C // 2]
    b_last = b[:, :, :, C - 1:]
    scores = jnp.einsum('bhntd,bhnsd->bhnts', q * jnp.exp(b - b_mid), k * jnp.exp(b_mid - b))
    lower_tri = jnp.tril(jnp.ones((C, C), dtype=bool))
    scores = jnp.where(lower_tri, scores, 0.0)
    o_intra = jnp.einsum('bhnts,bhnsv->bhntv', scores, v)
    q_inter = q * jnp.exp(b)
    k_end = k * jnp.exp(b_last - b)
    decay = jnp.exp(b_last[:, :, :, 0])

    def step(state, xs):
        qc, kc, vc, dc = xs
        o = jnp.einsum('bhtd,bhdv->bhtv', qc, state)
        state = dc[..., None] * state + jnp.einsum('bhtd,bhtv->bhdv', kc, vc)
        return state, o

    xs = tuple(jnp.moveaxis(t, 2, 0) for t in (q_inter, k_end, v, decay))
    _, o_inter = lax.scan(step, jnp.zeros((B, H, DK, DV), q.dtype), xs)
    o = o_intra + jnp.moveaxis(o_inter, 0, 2)
    return o.reshape(B, H, S, DV)


def _hgrn2_branch(q_in, i_in, zf_fw, zf_bw, g_in, lb_fw, lb_bw, norm_g):
    B, S, _ = q_in.shape

    def heads(t):
        return t.astype(jnp.float32).reshape(B, S, HG_HEADS, HG_HEAD_DIM).transpose(0, 2, 1, 3)

    q = heads(q_in)
    v = heads(i_in)

    def direction(z, lb, flip):
        f = heads(lb + (1.0 - lb) * jax.nn.sigmoid(z.astype(jnp.float32)))
        qq, vv = q, v
        if flip:
            f, qq, vv = (jnp.flip(t, axis=2) for t in (f, q, v))
        o = _hgrn2_chunk_scan(qq, 1.0 - f, vv, jnp.log(f))
        return jnp.flip(o, axis=2) if flip else o

    o = direction(zf_fw, lb_fw, False) + direction(zf_bw, lb_bw, True)
    o = _rmsnorm(o.transpose(0, 2, 1, 3), norm_g).reshape(B, S, HG_WIDTH)
    return o.astype(g_in.dtype) * jax.nn.silu(g_in)


def _neighbourhood_attention(q, k, v, rpb):
    B, H, R, W, dh = q.shape
    KR = min(NA_ROWS_MAX, R)
    nqb = W // NA_KC
    qc = jnp.arange(W)
    cs = jnp.clip(qc - NA_KC // 2, 0, W - NA_KC)
    ks = jnp.minimum(cs[::NA_KC], W - NA_SPAN)
    key_cols = ks[:, None] + jnp.arange(NA_SPAN)
    qcols = qc.reshape(nqb, NA_KC)
    cs_b = cs.reshape(nqb, NA_KC)
    kc3 = key_cols[:, None, :]
    col_mask = (kc3 >= cs_b[:, :, None]) & (kc3 < cs_b[:, :, None] + NA_KC)
    col_off = jnp.clip(kc3 - qcols[:, :, None] + NA_KC - 1, 0, 2 * NA_KC - 2)
    col_bias = rpb.astype(jnp.float32)[:, :, col_off]
    scale = NA_HEAD_DIM ** -0.5

    def one_row(r):
        rs = jnp.clip(r - KR // 2, 0, R - KR)
        k_rows = lax.dynamic_slice_in_dim(k, rs, KR, axis=2)
        v_rows = lax.dynamic_slice_in_dim(v, rs, KR, axis=2)
        k_blk = jnp.take(k_rows, key_cols, axis=3)
        v_blk = jnp.take(v_rows, key_cols, axis=3)
        q_row = lax.dynamic_index_in_dim(q, r, axis=2, keepdims=False).reshape(B, H, nqb, NA_KC, dh)
        s = jnp.einsum('bhjqd,bhrjcd->bhjqrc', q_row, k_blk).astype(jnp.float32) * scale
        row_off = rs + jnp.arange(KR) - r + NA_ROWS_MAX - 1
        bias = jnp.take(col_bias, row_off, axis=1).transpose(0, 2, 3, 1, 4)
        s = jnp.where(col_mask[:, :, None, :], s + bias[None], -jnp.inf)
        p = jax.nn.softmax(s.reshape(B, H, nqb, NA_KC, KR * NA_SPAN), axis=-1)
        p = p.reshape(B, H, nqb, NA_KC, KR, NA_SPAN).astype(v.dtype)
        o = jnp.einsum('bhjqrc,bhrjcd->bhjqd', p, v_blk)
        return o.reshape(B, H, W, dh)

    return lax.map(one_row, jnp.arange(R))


def setup_inputs(seed: int = 0) -> dict:
    key = jax.random.key(seed)
    ks = jax.random.split(key, 12)
    f32 = jnp.float32
    x = jax.random.normal(ks[0], (BATCH, SEQ, D_MODEL), f32)
    c = jax.random.normal(ks[1], (BATCH, D_MODEL), f32)
    ada_w = jax.random.normal(ks[2], (DEPTH, D_MODEL, ADA_COLS), f32) * D_MODEL ** -0.5
    ada_b = jax.random.normal(ks[3], (DEPTH, ADA_COLS), f32) * 0.02
    w_in = jax.random.normal(ks[4], (DEPTH, D_MODEL, IN_COLS), f32) * D_MODEL ** -0.5
    lb_logits = jax.random.normal(ks[5], (2, DEPTH, HG_WIDTH), f32)
    hg_norm_g = 1.0 + 0.02 * jax.random.normal(ks[6], (DEPTH, HG_HEAD_DIM), f32)
    rpb = jax.random.normal(ks[7], (DEPTH, NA_HEADS, 2 * NA_ROWS_MAX - 1, 2 * NA_KC - 1), f32) * 0.1
    w_out = jax.random.normal(ks[8], (DEPTH, MIX_WIDTH, D_MODEL), f32) * (MIX_WIDTH ** -0.5 * DEEPNORM_BETA)
    ln_g = 1.0 + 0.02 * jax.random.normal(ks[9], (DEPTH, D_MODEL), f32)
    ln_b = 0.02 * jax.random.normal(ks[10], (DEPTH, D_MODEL), f32)
    return {"x": x, "c": c, "ada_w": ada_w, "ada_b": ada_b, "w_in": w_in, "lb_logits": lb_logits,
            "hg_norm_g": hg_norm_g, "rpb": rpb, "w_out": w_out, "ln_g": ln_g, "ln_b": ln_b}


def reference(x, c, ada_w, ada_b, w_in, lb_logits, hg_norm_g, rpb, w_out, ln_g, ln_b):
    B, S, D = x.shape
    R = S // GRID_W
    lb_fw_all = _hgrn2_lower_bounds(lb_logits[0])
    lb_bw_all = _hgrn2_lower_bounds(lb_logits[1])
    c_act = jax.nn.silu(c)
    split_pts = np.cumsum([HG_WIDTH] * 5 + [NA_WIDTH] * 3).tolist()

    def na_heads(t):
        return t.reshape(B, R, GRID_W, NA_HEADS, NA_HEAD_DIM).transpose(0, 3, 1, 2, 4)

    for l in range(DEPTH):
        mod = c_act @ ada_w[l] + ada_b[l]
        shift, scale, gate = jnp.split(mod, 3, axis=-1)
        h = (_layernorm(x) * (1.0 + scale[:, None, :]) + shift[:, None, :]).astype(x.dtype)
        proj = h @ w_in[l]
        q_h, i_h, zf_fw, zf_bw, g_h, q_n, k_n, v_n, g_n = jnp.split(proj, split_pts, axis=-1)
        y_hg = _hgrn2_branch(q_h, i_h, zf_fw, zf_bw, g_h, lb_fw_all[l], lb_bw_all[l], hg_norm_g[l])
        o_na = _neighbourhood_attention(na_heads(q_n), na_heads(k_n), na_heads(v_n), rpb[l])
        o_na = o_na.transpose(1, 0, 3, 2, 4).reshape(B, S, NA_WIDTH)
        y_na = o_na * jax.nn.silu(g_n)
        y = jnp.concatenate([y_hg, y_na], axis=-1) @ w_out[l]
        z = DEEPNORM_ALPHA * x + gate[:, None, :] * y
        x = (_layernorm(z) * ln_g[l] + ln_b[l]).astype(x.dtype)
    return x
```

```cpp
#include <hip/hip_runtime.h>
#include <hip/hip_cooperative_groups.h>
#include <cstdio>
#include <cstdint>
namespace pg8 {
#define PG8_LAS __attribute__((address_space(3)))
typedef unsigned short bf16_t;
typedef short bf16x8 __attribute__((ext_vector_type(8)));
typedef float f32x4 __attribute__((ext_vector_type(4)));
typedef unsigned u32x4 __attribute__((ext_vector_type(4)));
constexpr int BM = 256, BK = 64, HALF = 128, HTB = HALF * BK * 2  , STAGE_BYTES = 8 * HTB, NXCD = 8, WGM = 8;

__host__ __device__ __forceinline__ int lds_byte(int r, int c) { const int st = (r >> 4) * 2 + (c >> 5), rr = r & 15, cc = c & 31, ob = rr * 64 + cc * 2; return st * 1024 + (ob ^ (((ob >> 9) & 1) << 5)); }
__host__ __device__ __forceinline__ void stage_rc(int b, int& R, int& C) { const int st = b / 1024, sb = b % 1024, swz = sb ^ (((sb >> 9) & 1) << 5); R = (st >> 1) * 16 + swz / 64; C = (st & 1) * 32 + (swz % 64) / 2; }
__host__ __device__ __forceinline__ int perm32(int rho) { const int n = rho >> 4, i = rho & 15; return 8 * (i >> 2) + 4 * n + (i & 3); }

struct Unit { int pm, pn; };
struct Gemm { const bf16_t* A; const bf16_t* Bt; int M, N, K; };

struct StaticOrder {
    int nM, nN, nwg, G, c;
    __host__ __device__ void init(int M, int N, int G_, int c_) { nM = M / BM; nN = N / BM; nwg = nM * nN; G = G_; c = c_; }
    __host__ __device__ bool next(int i, Unit& u) const {
        const long L = (long)i * G + c; if (L >= nwg) return false;
        int wgid = (int)L; { const int q = nwg / NXCD, r = nwg % NXCD, xcd = wgid % NXCD, off = wgid / NXCD; wgid = (xcd < r ? xcd * (q + 1) : r * (q + 1) + (xcd - r) * q) + off; }
        const int nig = WGM * nN, gid = wgid / nig, fm = gid * WGM, gsz = (nM - fm) < WGM ? (nM - fm) : WGM;
        u.pm = fm + ((wgid % nig) % gsz); u.pn = (wgid % nig) / gsz; return true;
    }
    __device__ __forceinline__ void a_ready(const Unit&) const {}
    __device__ __forceinline__ void done(const Unit&) const {}
};

__device__ __forceinline__ unsigned cvt_pk_bf16(float lo, float hi) { unsigned r; asm volatile("v_cvt_pk_bf16_f32 %0, %1, %2" : "=v"(r) : "v"(lo), "v"(hi)); return r; }
typedef float f32x2 __attribute__((ext_vector_type(2)));
__device__ __forceinline__ f32x2 gelu_pk(f32x2 v) {
    const f32x2 av = __builtin_elementwise_abs(v), d = av * 0.2316418882f + 1.0f;
    f32x2 t; t.x = __builtin_amdgcn_rcpf(d.x); t.y = __builtin_amdgcn_rcpf(d.y);
    f32x2 q = t * 0.5307027145f + (-0.7265760135f); q = q * t + 0.7107068705f; q = q * t + (-0.142248368f); q = q * t + 0.127414796f; q = q * t;
    const f32x2 s = (v * v) * (-0.72134752044f);
    f32x2 e; e.x = __builtin_amdgcn_exp2f(s.x); e.y = __builtin_amdgcn_exp2f(s.y);
    const f32x2 m = v * (q * e), r = v - m;
    f32x2 o; o.x = v.x < 0.f ? m.x : r.x; o.y = v.y < 0.f ? m.y : r.y; return o;
}

template <int ACT  > struct EpiBf16 {
    static constexpr bool PERM = true, AFTER_DRAIN = false; static_assert(ACT == 0 || ACT == 1, "EpiBf16: ACT is 0 (none) or 1 (gelu_pk)");
    bf16_t* O; int ldc; const float* bias; int split_cols; size_t split_stride; float scale0;
    __device__ __forceinline__ void operator()(const f32x4 (&acc)[2][2][4][2], const Unit& u, int wr, int wc, int fr, int fq) const {
        const int row0 = u.pm * BM + wr * 64 + fr; int colt = u.pn * BM; bf16_t* base = O;
        float sc = 1.f; if (split_cols) { const int t = colt / split_cols; base += (size_t)t * split_stride; colt -= t * split_cols; if (t == 0) sc = scale0; }
        const int col0 = colt + wc * 32 + 8 * fq, bcol0 = u.pn * BM + wc * 32 + 8 * fq;
        f32x4 bv[2][2];
#pragma unroll
        for (int bj = 0; bj < 2; ++bj)
#pragma unroll
            for (int n = 0; n < 2; ++n) bv[bj][n] = bias ? *(const f32x4*)(bias + bcol0 + bj * HALF + 4 * n) : (f32x4){0.f, 0.f, 0.f, 0.f};
#pragma unroll
        for (int ai = 0; ai < 2; ++ai)
#pragma unroll
            for (int m = 0; m < 4; ++m) { bf16_t* rowp = base + (size_t)(row0 + ai * HALF + m * 16) * ldc + col0;
#pragma unroll
                for (int bj = 0; bj < 2; ++bj) { f32x4 v0 = acc[ai][bj][m][0] + bv[bj][0], v1 = acc[ai][bj][m][1] + bv[bj][1];
                    if (ACT == 1) { f32x2 a = gelu_pk((f32x2){v0[0], v0[1]}), b = gelu_pk((f32x2){v0[2], v0[3]}), c = gelu_pk((f32x2){v1[0], v1[1]}), d = gelu_pk((f32x2){v1[2], v1[3]});
                        v0 = (f32x4){a.x, a.y, b.x, b.y}; v1 = (f32x4){c.x, c.y, d.x, d.y}; }
                    v0 = v0 * sc; v1 = v1 * sc; u32x4 w; w.x = cvt_pk_bf16(v0[0], v0[1]); w.y = cvt_pk_bf16(v0[2], v0[3]); w.z = cvt_pk_bf16(v1[0], v1[1]); w.w = cvt_pk_bf16(v1[2], v1[3]);
                    *(u32x4*)(rowp + bj * HALF) = w; } }
    }
};

struct PanelStats {
    unsigned* xbuf;
    unsigned* cnt;
    unsigned* tmo;
    int ntn; float eps;
    unsigned code;
    __device__ __forceinline__ bool run(const f32x4 (&v)[2][2][4][2], const Unit& u, int wr, int wc, int fr, int fq, PG8_LAS unsigned char* lds, int wid, int lane) const {
        typedef float f32x2v __attribute__((ext_vector_type(2)));
        PG8_LAS f32x2v* P = (PG8_LAS f32x2v*)lds;
        PG8_LAS f32x2v* S = (PG8_LAS f32x2v*)(lds + 8192);
        PG8_LAS unsigned* flag = (PG8_LAS unsigned*)(lds + 8192 + 2048);
#pragma unroll
        for (int ai = 0; ai < 2; ++ai)
#pragma unroll
            for (int m = 0; m < 4; ++m) {
                float s = 0.f;
#pragma unroll
                for (int bj = 0; bj < 2; ++bj)
#pragma unroll
                    for (int n = 0; n < 2; ++n) { const f32x4 x = v[ai][bj][m][n]; s += (x[0] + x[1]) + (x[2] + x[3]); }
                s += __shfl_xor(s, 16); s += __shfl_xor(s, 32);
                const float mw = s * (1.0f / 64.0f); float q = 0.f;
#pragma unroll
                for (int bj = 0; bj < 2; ++bj)
#pragma unroll
                    for (int n = 0; n < 2; ++n) { const f32x4 d = v[ai][bj][m][n] - mw; q += (d[0] * d[0] + d[1] * d[1]) + (d[2] * d[2] + d[3] * d[3]); }
                q += __shfl_xor(q, 16); q += __shfl_xor(q, 32);
                if (fq == 0) P[(ai * HALF + wr * 64 + m * 16 + fr) * 4 + wc] = (f32x2v){mw, q};
            }
        asm volatile("s_waitcnt lgkmcnt(0)" ::: "memory"); __builtin_amdgcn_s_barrier(); asm volatile("" ::: "memory");
#if defined(BROKEN_EXCHANGE_NO_WAIT)
#warning BROKEN CONTROL BUILD: the row-statistics exchange does not wait; results are wrong by design
        if (blockIdx.x >= 64) { const long long t0_ = clock64(); while (clock64() - t0_ < 60000) __builtin_amdgcn_s_sleep(8); }
#endif
        const int row = wid * 32 + (lane & 31);
        if (lane < 32) {
            const f32x2v a = P[row * 4 + 0], b = P[row * 4 + 1], c = P[row * 4 + 2], d = P[row * 4 + 3];
            const float mt = (a.x + b.x + c.x + d.x) * 0.25f;
            const float da = a.x - mt, db = b.x - mt, dc = c.x - mt, dd = d.x - mt;
            const float m2 = (a.y + b.y) + (c.y + d.y) + 64.0f * ((da * da + db * db) + (dc * dc + dd * dd));
            unsigned long long* slot = (unsigned long long*)xbuf + ((size_t)(u.pm * BM + row) * 4 + u.pn);
            __hip_atomic_store(slot, ((unsigned long long)__float_as_uint(m2) << 32) | __float_as_uint(mt), __ATOMIC_RELAXED, __HIP_MEMORY_SCOPE_AGENT);
        }
        asm volatile("s_waitcnt vmcnt(0)" ::: "memory");
        if (lane == 0) __hip_atomic_fetch_add(cnt + 64 * u.pm, 1u, __ATOMIC_RELAXED, __HIP_MEMORY_SCOPE_AGENT);
        if (wid == 0) {
            bool dead = false; const unsigned long long t0 = __builtin_amdgcn_s_memrealtime(); const unsigned want = 8u * (unsigned)ntn;
            for (;;) {
#if defined(BROKEN_EXCHANGE_NO_WAIT)
                break;
#endif
                if ((unsigned)__builtin_amdgcn_readfirstlane(__hip_atomic_load(cnt + 64 * u.pm, __ATOMIC_RELAXED, __HIP_MEMORY_SCOPE_AGENT)) >= want) break;
                if (__builtin_amdgcn_s_memrealtime() - t0 > 2000000ull) {
                    if (lane == 0) { unsigned expect = 0u; __hip_atomic_compare_exchange_strong(tmo + 1, &expect, code | (unsigned)(u.pm & 0xff), __ATOMIC_RELAXED, __ATOMIC_RELAXED, __HIP_MEMORY_SCOPE_AGENT);
                                     __hip_atomic_store(tmo, 1u, __ATOMIC_RELAXED, __HIP_MEMORY_SCOPE_AGENT); }
                    dead = true; break; }
                __builtin_amdgcn_s_sleep(2);
            }
            __builtin_amdgcn_fence(__ATOMIC_ACQUIRE, "agent");
            if (lane == 0) flag[0] = dead ? 1u : 0u;
        }
        asm volatile("s_waitcnt vmcnt(0) lgkmcnt(0)" ::: "memory"); __builtin_amdgcn_s_barrier(); asm volatile("" ::: "memory");
        const bool bad = flag[0] != 0u;
        if (lane < 32) {
            const unsigned long long* slot = (const unsigned long long*)xbuf + (size_t)(u.pm * BM + row) * 4; float mt[4], m2[4]; float ms = 0.f;
#pragma unroll
            for (int t = 0; t < 4; ++t) { if (t < ntn) { const unsigned long long w = __hip_atomic_load(slot + t, __ATOMIC_RELAXED, __HIP_MEMORY_SCOPE_AGENT); mt[t] = __uint_as_float((unsigned)w); m2[t] = __uint_as_float((unsigned)(w >> 32)); } else { mt[t] = 0.f; m2[t] = 0.f; } ms += mt[t]; }
            const float mean = ms / (float)ntn; float q = 0.f;
#pragma unroll
            for (int t = 0; t < 4; ++t) if (t < ntn) { const float dm = mt[t] - mean; q += m2[t] + 256.0f * dm * dm; }
            S[row] = (f32x2v){mean, 1.0f / sqrtf(q / (256.0f * (float)ntn) + eps)};
        }
        asm volatile("s_waitcnt lgkmcnt(0)" ::: "memory"); __builtin_amdgcn_s_barrier(); asm volatile("" ::: "memory");
        return bad;
    }
};
struct EpiLnRes {
    static constexpr bool PERM = false, AFTER_DRAIN = true;
    const float* base; float* out; int ldc; const float* bias; PanelStats st; unsigned poison;
    __device__ __forceinline__ void fused(f32x4 (&acc)[2][2][4][2], const Unit& u, int wr, int wc, int fr, int fq, PG8_LAS unsigned char* lds, int wid, int lane) const {
        typedef float f32x2v __attribute__((ext_vector_type(2)));
        const PG8_LAS f32x2v* S = (const PG8_LAS f32x2v*)(lds + 8192);
        const int col0 = u.pn * BM + wc * 32 + 4 * fq;
#pragma unroll
        for (int bj = 0; bj < 2; ++bj)
#pragma unroll
            for (int n = 0; n < 2; ++n) { const f32x4 bv = bias ? *(const f32x4*)(bias + col0 + bj * HALF + n * 16) : (f32x4){0.f, 0.f, 0.f, 0.f};
#pragma unroll
                for (int ai = 0; ai < 2; ++ai)
#pragma unroll
                    for (int m = 0; m < 4; ++m) acc[ai][bj][m][n] += bv; }
        f32x4 pre[4][2][2];
#pragma unroll
        for (int m = 0; m < 4; ++m) { const size_t off = (size_t)(u.pm * BM + wr * 64 + m * 16 + fr) * ldc + col0;
#pragma unroll
            for (int bj = 0; bj < 2; ++bj)
#pragma unroll
                for (int n = 0; n < 2; ++n) pre[m][bj][n] = *(const f32x4*)(base + off + bj * HALF + n * 16); }
        const bool bad = st.run(acc, u, wr, wc, fr, fq, lds, wid, lane) || poison != 0u;
        const float qnan = __builtin_nanf("");
#pragma unroll
        for (int ai = 0; ai < 2; ++ai)
#pragma unroll
            for (int m = 0; m < 4; ++m) { const int r = ai * HALF + wr * 64 + m * 16 + fr; const f32x2v sr = S[r]; const size_t off = (size_t)(u.pm * BM + r) * ldc + col0;
#pragma unroll
                for (int bj = 0; bj < 2; ++bj)
#pragma unroll
                    for (int n = 0; n < 2; ++n) { const f32x4 bs = ai == 0 ? pre[m][bj][n] : *(const f32x4*)(base + off + bj * HALF + n * 16); f32x4 o = bs + (acc[ai][bj][m][n] - sr.x) * sr.y;
                        if (bad) o = (f32x4){qnan, qnan, qnan, qnan}; *(f32x4*)(out + off + bj * HALF + n * 16) = o; }
                if (m & 1) asm volatile("" ::: "memory"); }
    }
};
struct EpiLnResLn {
    static constexpr bool PERM = false, AFTER_DRAIN = true;
    const float* base; float* out; bf16_t* xn; int ldc; const float* bias; PanelStats st1, st2; unsigned poison;
    __device__ __forceinline__ void fused(f32x4 (&acc)[2][2][4][2], const Unit& u, int wr, int wc, int fr, int fq, PG8_LAS unsigned char* lds, int wid, int lane) const {
        typedef float f32x2v __attribute__((ext_vector_type(2))); typedef unsigned u32x2v __attribute__((ext_vector_type(2)));
        const PG8_LAS f32x2v* S = (const PG8_LAS f32x2v*)(lds + 8192);
        const int col0 = u.pn * BM + wc * 32 + 4 * fq;
#pragma unroll
        for (int bj = 0; bj < 2; ++bj)
#pragma unroll
            for (int n = 0; n < 2; ++n) { const f32x4 bv = bias ? *(const f32x4*)(bias + col0 + bj * HALF + n * 16) : (f32x4){0.f, 0.f, 0.f, 0.f};
#pragma unroll
                for (int ai = 0; ai < 2; ++ai)
#pragma unroll
                    for (int m = 0; m < 4; ++m) acc[ai][bj][m][n] += bv; }
        bool bad = st1.run(acc, u, wr, wc, fr, fq, lds, wid, lane) || poison != 0u;
        const float qnan = __builtin_nanf("");
#pragma unroll
        for (int ai = 0; ai < 2; ++ai)
#pragma unroll
            for (int m = 0; m < 4; ++m) { const int r = ai * HALF + wr * 64 + m * 16 + fr; const f32x2v sr = S[r]; const size_t off = (size_t)(u.pm * BM + r) * ldc + col0;
#pragma unroll
                for (int bj = 0; bj < 2; ++bj)
#pragma unroll
                    for (int n = 0; n < 2; ++n) { const f32x4 bs = *(const f32x4*)(base + off + bj * HALF + n * 16); acc[ai][bj][m][n] = bs + (acc[ai][bj][m][n] - sr.x) * sr.y; }
                asm volatile("" : "+v"(acc[ai][0][m][0]), "+v"(acc[ai][0][m][1]), "+v"(acc[ai][1][m][0]), "+v"(acc[ai][1][m][1]));
                if (m & 1) asm volatile("" ::: "memory"); }
        const bool bad1 = bad;
        bad = st2.run(acc, u, wr, wc, fr, fq, lds, wid, lane) || bad;
#pragma unroll
        for (int ai = 0; ai < 2; ++ai)
#pragma unroll
            for (int m = 0; m < 4; ++m) { const int r = ai * HALF + wr * 64 + m * 16 + fr; const f32x2v sr = S[r]; const size_t off = (size_t)(u.pm * BM + r) * ldc + col0;
#pragma unroll
                for (int bj = 0; bj < 2; ++bj)
#pragma unroll
                    for (int n = 0; n < 2; ++n) { const f32x4 x1 = acc[ai][bj][m][n]; *(f32x4*)(out + off + bj * HALF + n * 16) = bad1 ? (f32x4){qnan, qnan, qnan, qnan} : x1;
                        const f32x4 o = (x1 - sr.x) * sr.y; u32x2v w; w.x = cvt_pk_bf16(o[0], o[1]); w.y = cvt_pk_bf16(o[2], o[3]);
                        if (bad) { w.x = 0x7fc07fc0u; w.y = 0x7fc07fc0u; } *(u32x2v*)(xn + off + bj * HALF + n * 16) = w; }
                asm volatile("" ::: "memory"); }
    }
};

template <class Epi, class Sched, bool ALIGN_EPI = false, bool SP2 = false>
__device__ __forceinline__ void gemm_phase(PG8_LAS unsigned char* lds, const Gemm g, const Sched& S, const Epi& E) {
    int tid_ = threadIdx.x; asm volatile("" : "+v"(tid_)); const int tid = tid_, wid = __builtin_amdgcn_readfirstlane(tid >> 6), lane = tid & 63, wr = wid >> 2, wc = wid & 3, fr = lane & 15, fq = lane >> 4;
    const int K = g.K, nt = K / BK;
    unsigned voffA[2], voffB[2];
#pragma unroll
    for (int i = 0; i < 2; ++i) { int R, C; stage_rc(tid * 16 + i * 8192, R, C); const int Rb = Epi::PERM ? ((R & ~31) + perm32(R & 31)) : R;
        voffA[i] = (unsigned)(R * K + C) * 2u; voffB[i] = (unsigned)(Rb * K + C) * 2u; }
    const size_t kstep = (size_t)(BK * 2);
    const size_t hstep = (size_t)HALF * K * 2;
    const size_t tstep = 2 * hstep;
    const unsigned ldsw = (unsigned)wid * 1024u;
    const int aoff = lds_byte(wr * 64 + fr, fq * 8), boff = lds_byte(wc * 32 + fr, fq * 8);
#define PG8_SA(b, h) (((b) * 2 + (h)) * HTB)
#define PG8_SB(b, h) ((4 + (b) * 2 + (h)) * HTB)
#define PG8_STAGE(bufoff, gbase, voff) do { _Pragma("unroll") for (int _i = 0; _i < 2; ++_i) \
        __builtin_amdgcn_global_load_lds((const unsigned*)((const char*)(gbase) + (voff)[_i]), (PG8_LAS unsigned*)(lds + (bufoff) + ldsw + _i * 8192), 16, 0, 0); } while (0)
#define PG8_LDA(dst, b, h) do { _Pragma("unroll") for (int m = 0; m < 4; ++m) _Pragma("unroll") for (int k = 0; k < 2; ++k) dst[m][k] = *(const PG8_LAS bf16x8*)(lds + PG8_SA(b, h) + aoff + m * 2048 + k * 1024); } while (0)
#define PG8_LDB(dst, b, h) do { _Pragma("unroll") for (int n = 0; n < 2; ++n) _Pragma("unroll") for (int k = 0; k < 2; ++k) dst[n][k] = *(const PG8_LAS bf16x8*)(lds + PG8_SB(b, h) + boff + n * 2048 + k * 1024); } while (0)
#define PG8_MMA(ai, bj, At, Bt) do { __builtin_amdgcn_s_setprio(1); _Pragma("unroll") for (int m = 0; m < 4; ++m) _Pragma("unroll") for (int n = 0; n < 2; ++n) _Pragma("unroll") for (int k = 0; k < 2; ++k) \
        acc[ai][bj][m][n] = __builtin_amdgcn_mfma_f32_16x16x32_bf16(Bt[n][k], At[m][k], acc[ai][bj][m][n], 0, 0, 0); __builtin_amdgcn_s_setprio(0); } while (0)
#define PG8_WAIT_V(n) asm volatile("s_waitcnt vmcnt(" #n ")" ::: "memory")
#define PG8_WAIT_L(n) asm volatile("s_waitcnt lgkmcnt(" #n ")" ::: "memory")
#define PG8_BAR __builtin_amdgcn_s_barrier()
#define PG8_SCHED __builtin_amdgcn_sched_barrier(0)
    Unit cur, nxt; int ui = 0;
    if (!S.next(0, cur)) return;
    f32x4 acc[2][2][4][2];
#pragma unroll
    for (int a = 0; a < 2; ++a)
#pragma unroll
        for (int b = 0; b < 2; ++b)
#pragma unroll
            for (int m = 0; m < 4; ++m)
#pragma unroll
                for (int n = 0; n < 2; ++n) acc[a][b][m][n] = (f32x4){0.f, 0.f, 0.f, 0.f};
    bf16x8 At[4][2], B0[2][2], B1[2][2];
    const char* cA = (const char*)g.A + (size_t)cur.pm * tstep; const char* cB = (const char*)g.Bt + (size_t)cur.pn * tstep;
    S.a_ready(cur);
    if constexpr (SP2) {
        PG8_STAGE(PG8_SB(0, 0), cB, voffB); PG8_STAGE(PG8_SB(0, 1), cB + hstep, voffB); PG8_STAGE(PG8_SA(0, 0), cA, voffA); PG8_STAGE(PG8_SA(0, 1), cA + hstep, voffA);
        if (wr == 1) PG8_BAR;
        PG8_WAIT_V(2); PG8_BAR;
        PG8_STAGE(PG8_SB(1, 0), cB + kstep, voffB); PG8_STAGE(PG8_SA(1, 0), cA + kstep, voffA); PG8_STAGE(PG8_SB(1, 1), cB + hstep + kstep, voffB);
        PG8_WAIT_V(6); PG8_BAR;
    } else {
        PG8_STAGE(PG8_SB(0, 0), cB, voffB); PG8_STAGE(PG8_SA(0, 0), cA, voffA); PG8_STAGE(PG8_SB(0, 1), cB + hstep, voffB); PG8_STAGE(PG8_SA(0, 1), cA + hstep, voffA);
        if (wr == 1) PG8_BAR;
        PG8_WAIT_V(4); PG8_BAR;
        PG8_STAGE(PG8_SB(1, 0), cB + kstep, voffB); PG8_STAGE(PG8_SA(1, 0), cA + kstep, voffA); PG8_STAGE(PG8_SB(1, 1), cB + hstep + kstep, voffB);
        PG8_WAIT_V(6); PG8_BAR;
    }
    for (;;) {
        const bool has_next = S.next(ui + 1, nxt);
        const char* nA = has_next ? (const char*)g.A + (size_t)nxt.pm * tstep : cA; const char* nB = has_next ? (const char*)g.Bt + (size_t)nxt.pn * tstep : cB;
        for (int t = 0; t < nt; t += 2) {
            const bool last = (t == nt - 2);
            const char* a1 = cA + (size_t)(t + 1) * kstep;
            const char* a2 = last ? nA : cA + (size_t)(t + 2) * kstep; const char* b2 = last ? nB : cB + (size_t)(t + 2) * kstep;
            const char* a3 = a2 + kstep; const char* b3 = b2 + kstep;
            if (last && has_next) S.a_ready(nxt);
            if constexpr (SP2) {
            PG8_LDB(B0, 0, 0); PG8_LDB(B1, 0, 1); PG8_SCHED; PG8_LDA(At, 0, 0); PG8_STAGE(PG8_SA(1, 1), a1 + hstep, voffA);
            PG8_WAIT_V(8); PG8_WAIT_L(0); PG8_BAR; PG8_MMA(0, 0, At, B0); PG8_MMA(0, 1, At, B1); PG8_BAR; PG8_SCHED;
            PG8_LDA(At, 0, 1); PG8_STAGE(PG8_SB(0, 0), b2, voffB); PG8_STAGE(PG8_SB(0, 1), b2 + hstep, voffB); PG8_STAGE(PG8_SA(0, 0), a2, voffA);
            PG8_WAIT_V(8); PG8_WAIT_L(0); PG8_BAR; PG8_MMA(1, 0, At, B0); PG8_MMA(1, 1, At, B1); PG8_BAR; PG8_SCHED;
            PG8_LDB(B0, 1, 0); PG8_LDB(B1, 1, 1); PG8_SCHED; PG8_LDA(At, 1, 0); PG8_STAGE(PG8_SA(0, 1), a2 + hstep, voffA);
            PG8_WAIT_V(8); PG8_WAIT_L(0); PG8_BAR; PG8_MMA(0, 0, At, B0); PG8_MMA(0, 1, At, B1); PG8_BAR; PG8_SCHED;
            PG8_LDA(At, 1, 1); PG8_STAGE(PG8_SB(1, 0), b3, voffB); PG8_STAGE(PG8_SB(1, 1), b3 + hstep, voffB); PG8_STAGE(PG8_SA(1, 0), a3, voffA);
            PG8_WAIT_V(8); PG8_WAIT_L(0); PG8_BAR; PG8_MMA(1, 0, At, B0); PG8_MMA(1, 1, At, B1); PG8_BAR; PG8_SCHED;
            } else {
            PG8_LDB(B0, 0, 0); PG8_SCHED; PG8_LDA(At, 0, 0); PG8_STAGE(PG8_SA(1, 1), a1 + hstep, voffA);
            PG8_WAIT_L(8); PG8_BAR; PG8_WAIT_L(0); PG8_MMA(0, 0, At, B0); PG8_BAR; PG8_SCHED;
            PG8_LDB(B1, 0, 1); PG8_STAGE(PG8_SB(0, 0), b2, voffB);
            PG8_BAR; PG8_WAIT_L(0); PG8_MMA(0, 1, At, B1); PG8_BAR;
            PG8_LDA(At, 0, 1); PG8_STAGE(PG8_SA(0, 0), a2, voffA);
            PG8_BAR; PG8_WAIT_L(0); PG8_MMA(1, 0, At, B0); PG8_BAR; PG8_SCHED;
            PG8_STAGE(PG8_SB(0, 1), b2 + hstep, voffB);
            PG8_WAIT_V(6); PG8_BAR; PG8_MMA(1, 1, At, B1); PG8_BAR;
            PG8_LDB(B0, 1, 0); PG8_SCHED; PG8_LDA(At, 1, 0); PG8_STAGE(PG8_SA(0, 1), a2 + hstep, voffA);
            PG8_WAIT_L(8); PG8_BAR; PG8_WAIT_L(0); PG8_MMA(0, 0, At, B0); PG8_BAR; PG8_SCHED;
            PG8_LDB(B1, 1, 1); PG8_STAGE(PG8_SB(1, 0), b3, voffB);
            PG8_BAR; PG8_WAIT_L(0); PG8_MMA(0, 1, At, B1); PG8_BAR;
            PG8_LDA(At, 1, 1); PG8_STAGE(PG8_SA(1, 0), a3, voffA);
            PG8_BAR; PG8_WAIT_L(0); PG8_MMA(1, 0, At, B0); PG8_BAR; PG8_SCHED;
            PG8_STAGE(PG8_SB(1, 1), b3 + hstep, voffB);
            PG8_WAIT_V(6); PG8_BAR; PG8_MMA(1, 1, At, B1); PG8_BAR;
            }
        }
        if constexpr (ALIGN_EPI) { if (wr == 0) PG8_BAR; }
        if constexpr (!Epi::AFTER_DRAIN) { E(acc, cur, wr, wc, fr, fq); S.done(cur); }
        if (!has_next) break;
#pragma unroll
        for (int a = 0; a < 2; ++a)
#pragma unroll
            for (int b = 0; b < 2; ++b)
#pragma unroll
                for (int m = 0; m < 4; ++m)
#pragma unroll
                    for (int n = 0; n < 2; ++n) acc[a][b][m][n] = (f32x4){0.f, 0.f, 0.f, 0.f};
        cur = nxt; cA = nA; cB = nB; ++ui;
        if constexpr (ALIGN_EPI) { if (wr == 1) PG8_BAR; }
    }
    PG8_WAIT_V(0);
    if constexpr (!ALIGN_EPI) { if (wr == 0) PG8_BAR; }
    PG8_BAR;
    if constexpr (Epi::AFTER_DRAIN) { E.fused(acc, cur, wr, wc, fr, fq, lds, wid, lane); S.done(cur); }
#undef PG8_SA
#undef PG8_SB
#undef PG8_STAGE
#undef PG8_LDA
#undef PG8_LDB
#undef PG8_MMA
#undef PG8_WAIT_V
#undef PG8_WAIT_L
#undef PG8_BAR
#undef PG8_SCHED
}
}
namespace cg = cooperative_groups;
#define GAS __attribute__((address_space(1)))
#define LAS __attribute__((address_space(3)))
typedef unsigned short bf16;
typedef unsigned v4u __attribute__((ext_vector_type(4)));
typedef unsigned v2u __attribute__((ext_vector_type(2)));
typedef float f32x4 __attribute__((ext_vector_type(4)));
typedef short bf16x8 __attribute__((ext_vector_type(8)));

constexpr int NB = 8, SEQ = 2048, DM = 1024, DEPTH = 4, MTOK = NB * SEQ;
constexpr int INC = 9216, ADAC = 3072, MIXW = 2048;
constexpr int C_QH = 0, C_IH = 1024, C_ZFW = 2048, C_ZBW = 3072, C_GH = 4096, C_QN = 5120, C_KN = 6144, C_VN = 7168, C_GN = 8192;
constexpr float DN_ALPHA = 1.6817928305074290f;
constexpr float LN_EPS = 1e-5f, RMS_EPS = 1e-6f;

constexpr size_t MiB = 1u << 20;
constexpr size_t WS_CTL = 0, CTL_ZERO_BYTES = 1 * MiB;
constexpr size_t WS_MOD = 1 * MiB;
constexpr size_t WS_LB = 1 * MiB + 512 * 1024;
constexpr size_t WS_WTIN = 2 * MiB;
constexpr size_t WS_WTOUT = 74 * MiB;
constexpr size_t WS_H = 90 * MiB;
constexpr size_t WS_P = 122 * MiB;
constexpr size_t WS_Y = 410 * MiB;
constexpr size_t WS_OBUF = 474 * MiB;
constexpr size_t WS_END = 538 * MiB;

constexpr int LDS_BYTES = 147456;
constexpr int NPHASE = 2 + 4 * DEPTH;

__device__ __forceinline__ float bf2f(bf16 v) { return __uint_as_float((unsigned)v << 16); }
__device__ __forceinline__ unsigned f2bf(float f) { unsigned u = __float_as_uint(f); return (u + 0x7fffu + ((u >> 16) & 1u)) >> 16; }
__device__ __forceinline__ unsigned pk2(float lo, float hi) { return f2bf(lo) | (f2bf(hi) << 16); }
__device__ __forceinline__ float wave_sum(float v) {
#pragma unroll
    for (int o = 1; o < 64; o <<= 1) v += __shfl_xor(v, o);
    return v;
}
__device__ __forceinline__ float wave_max(float v) {
#pragma unroll
    for (int o = 1; o < 64; o <<= 1) v = fmaxf(v, __shfl_xor(v, o));
    return v;
}
__device__ __forceinline__ float sigmoidf_(float z) { return 1.0f / (1.0f + __expf(-z)); }

struct Args { const float* in[11]; float* out; unsigned char* ws; int ph_lo, ph_hi, coop, pad; };

__device__ __forceinline__ void p0_transpose_item(const float* W, int K, int N, bf16* WT, LAS float* scr, int item, int lane) {
    const int nblk = N / 32, kb = item / nblk, nb = item % nblk, k0 = 64 * kb, n0 = 32 * nb;
#pragma unroll 8
    for (int i = 0; i < 32; ++i) { const int kk = 2 * i + (lane >> 5); scr[kk * 33 + (lane & 31)] = W[(size_t)(k0 + kk) * N + n0 + (lane & 31)]; }
    asm volatile("s_waitcnt lgkmcnt(0)" ::: "memory");
    const int c = lane & 7;
#pragma unroll
    for (int j = 0; j < 4; ++j) { const int n = (lane >> 3) + 8 * j; const LAS float* s = scr + (8 * c) * 33 + n;
        v4u o; o.x = pk2(s[0 * 33], s[1 * 33]); o.y = pk2(s[2 * 33], s[3 * 33]); o.z = pk2(s[4 * 33], s[5 * 33]); o.w = pk2(s[6 * 33], s[7 * 33]);
        *(v4u*)(WT + (size_t)(n0 + n) * K + k0 + 8 * c) = o; }
    asm volatile("s_waitcnt lgkmcnt(0)" ::: "memory");
}

struct EpiZ {
    static constexpr bool PERM = false, AFTER_DRAIN = false;
    const float* xin; float* out; const float* gate;
    __device__ __forceinline__ void operator()(const pg8::f32x4 (&acc)[2][2][4][2], const pg8::Unit& u, int wr, int wc, int fr, int fq) const {
        const int col0 = u.pn * 256 + wc * 32 + 4 * fq;
        const float* g = gate + (size_t)(u.pm >> 3) * ADAC;
#pragma unroll
        for (int ai = 0; ai < 2; ++ai)
#pragma unroll
            for (int m = 0; m < 4; ++m) { const size_t r = (size_t)u.pm * 256 + ai * 128 + wr * 64 + m * 16 + fr;
#pragma unroll
                for (int bj = 0; bj < 2; ++bj)
#pragma unroll
                    for (int n = 0; n < 2; ++n) { const int c = col0 + bj * 128 + n * 16;
                        const f32x4 g4 = *(const f32x4*)(g + c); const f32x4 xv = *(const f32x4*)(xin + r * DM + c);
                        const pg8::f32x4 av = acc[ai][bj][m][n];
                        f32x4 o; o.x = DN_ALPHA * xv.x + g4.x * av[0]; o.y = DN_ALPHA * xv.y + g4.y * av[1]; o.z = DN_ALPHA * xv.z + g4.z * av[2]; o.w = DN_ALPHA * xv.w + g4.w * av[3];
                        *(f32x4*)(out + r * DM + c) = o; } }
    }
};

struct Ctx {
    LAS unsigned char* lds; int tid, lane, wave;
    const Args* a;
    __device__ __forceinline__ const float* in(int k) const { return a->in[k]; }
    __device__ __forceinline__ unsigned char* wsp() const { return a->ws; }
#define CTXP(name, expr) __device__ __forceinline__ auto name() const { return expr; }
    CTXP(x, in(0)) CTXP(c, in(1)) CTXP(ada_w, in(2)) CTXP(ada_b, in(3)) CTXP(w_in, in(4)) CTXP(lb_logits, in(5)) CTXP(hg_norm_g, in(6))
    CTXP(rpb, in(7)) CTXP(w_out, in(8)) CTXP(ln_g, in(9)) CTXP(ln_b, in(10)) CTXP(out, a->out)
    CTXP(mod, (float*)(wsp() + WS_MOD)) CTXP(lb, (float*)(wsp() + WS_LB)) CTXP(wt_in, (bf16*)(wsp() + WS_WTIN)) CTXP(wt_out, (bf16*)(wsp() + WS_WTOUT))
    CTXP(H, (bf16*)(wsp() + WS_H)) CTXP(P, (bf16*)(wsp() + WS_P)) CTXP(Y, (bf16*)(wsp() + WS_Y)) CTXP(obuf, (float*)(wsp() + WS_OBUF))
#undef CTXP
};

__device__ __forceinline__ void phase_prologue(Ctx& F) {
    LAS float* scr = (LAS float*)(F.lds + F.wave * 16384);
    const int gw = blockIdx.x * 8 + F.wave, NGW = gridDim.x * 8;
    constexpr int I_IN = (DM / 64) * (INC / 32), I_OUT = (MIXW / 64) * (DM / 32);
    for (int it = gw; it < DEPTH * (I_IN + I_OUT); it += NGW) {
        int l = it / (I_IN + I_OUT), r = it % (I_IN + I_OUT);
        if (r < I_IN) p0_transpose_item(F.w_in() + (size_t)l * DM * INC, DM, INC, F.wt_in() + (size_t)l * INC * DM, scr, r, F.lane);
        else p0_transpose_item(F.w_out() + (size_t)l * MIXW * DM, MIXW, DM, F.wt_out() + (size_t)l * DM * MIXW, scr, r - I_IN, F.lane);
    }
    __syncthreads();
    LAS float* sc = (LAS float*)F.lds;
    LAS float* red = (LAS float*)(F.lds + 32768);
    for (int it = blockIdx.x; it < DEPTH * (ADAC / 64); it += gridDim.x) {
        const int l = it / (ADAC / 64), j0 = (it % (ADAC / 64)) * 64;
        for (int i = F.tid; i < NB * DM; i += 512) { const float v = F.c()[i]; sc[i] = v * sigmoidf_(v); }
        __syncthreads();
        const int kq = F.tid >> 6, jj = F.tid & 63;
        float acc[8];
#pragma unroll
        for (int b = 0; b < 8; ++b) acc[b] = 0.f;
        const float* w = F.ada_w() + (size_t)l * DM * ADAC + j0 + jj;
#pragma unroll 8
        for (int k = kq; k < DM; k += 8) { const float wv = w[(size_t)k * ADAC];
#pragma unroll
            for (int b = 0; b < 8; ++b) acc[b] += sc[b * DM + k] * wv; }
#pragma unroll
        for (int b = 0; b < 8; ++b) red[(kq * 8 + b) * 64 + jj] = acc[b];
        __syncthreads();
        { const int b = F.tid >> 6; float s = 0.f;
#pragma unroll
          for (int q = 0; q < 8; ++q) s += red[(q * 8 + b) * 64 + jj];
          F.mod()[((size_t)l * NB + b) * ADAC + j0 + jj] = s + F.ada_b()[l * ADAC + j0 + jj]; }
        __syncthreads();
    }
    if (blockIdx.x == gridDim.x - 1) {
        for (int i = F.tid; i < 2 * 1024; i += 512) { const int ds = i >> 10, ch = i & 1023;
            float lg[4], mx = -1e30f;
#pragma unroll
            for (int l = 0; l < 4; ++l) { lg[l] = F.lb_logits()[(ds * 4 + l) * 1024 + ch]; mx = fmaxf(mx, lg[l]); }
            float s = 0.f;
#pragma unroll
            for (int l = 0; l < 4; ++l) { lg[l] = __expf(lg[l] - mx); s += lg[l]; }
            const float inv = 1.f / s; float cs = 0.f;
            F.lb()[(ds * 4 + 0) * 1024 + ch] = 0.f;
#pragma unroll
            for (int l = 1; l < 4; ++l) { cs += lg[l] * inv; F.lb()[(ds * 4 + l) * 1024 + ch] = cs; }
        }
    }
}

__device__ __forceinline__ void ln_mod_row(const float* xrow, const float* modb  , bf16* orow, int lane) {
    const f32x4* xr = (const f32x4*)xrow + lane;
    f32x4 v[4]; float s = 0.f;
#pragma unroll
    for (int j = 0; j < 4; ++j) { v[j] = xr[64 * j]; s += (v[j].x + v[j].y) + (v[j].z + v[j].w); }
    const float mean = wave_sum(s) * (1.f / DM); float s2 = 0.f;
#pragma unroll
    for (int j = 0; j < 4; ++j) { v[j] = v[j] - mean; s2 += (v[j].x * v[j].x + v[j].y * v[j].y) + (v[j].z * v[j].z + v[j].w * v[j].w); }
    const float rstd = 1.f / sqrtf(wave_sum(s2) * (1.f / DM) + LN_EPS);
    unsigned long long* o8 = (unsigned long long*)orow + lane;
#pragma unroll
    for (int j = 0; j < 4; ++j) { const f32x4 sh = *((const f32x4*)modb + lane + 64 * j), sc = *((const f32x4*)(modb + DM) + lane + 64 * j);
        const float a = v[j].x * rstd * (1.f + sc.x) + sh.x, b = v[j].y * rstd * (1.f + sc.y) + sh.y, c = v[j].z * rstd * (1.f + sc.z) + sh.z, d = v[j].w * rstd * (1.f + sc.w) + sh.w;
        o8[64 * j] = (unsigned long long)pk2(a, b) | ((unsigned long long)pk2(c, d) << 32); }
}
__device__ __forceinline__ void phase_ln0(Ctx& F) {
    const int gw = blockIdx.x * 8 + F.wave, NGW = gridDim.x * 8;
    for (int m = gw; m < MTOK; m += NGW) ln_mod_row(F.x() + (size_t)m * DM, F.mod() + (size_t)(0 * NB + (m >> 11)) * ADAC, F.H() + (size_t)m * DM, F.lane);
}
__device__ __forceinline__ void phase_ln(Ctx& F, int l) {
    const int gw = blockIdx.x * 8 + F.wave, NGW = gridDim.x * 8;
    for (int m = gw; m < MTOK; m += NGW) {
        f32x4* xr = (f32x4*)(F.out() + (size_t)m * DM) + F.lane;
        f32x4 v[4]; float s = 0.f;
#pragma unroll
        for (int j = 0; j < 4; ++j) { v[j] = xr[64 * j]; s += (v[j].x + v[j].y) + (v[j].z + v[j].w); }
        const float mean = wave_sum(s) * (1.f / DM); float s2 = 0.f;
#pragma unroll
        for (int j = 0; j < 4; ++j) { v[j] = v[j] - mean; s2 += (v[j].x * v[j].x + v[j].y * v[j].y) + (v[j].z * v[j].z + v[j].w * v[j].w); }
        const float rstd = 1.f / sqrtf(wave_sum(s2) * (1.f / DM) + LN_EPS);
        float t = 0.f;
#pragma unroll
        for (int j = 0; j < 4; ++j) { const f32x4 g = *((const f32x4*)(F.ln_g() + l * DM) + F.lane + 64 * j), b = *((const f32x4*)(F.ln_b() + l * DM) + F.lane + 64 * j);
            v[j].x = v[j].x * rstd * g.x + b.x; v[j].y = v[j].y * rstd * g.y + b.y; v[j].z = v[j].z * rstd * g.z + b.z; v[j].w = v[j].w * rstd * g.w + b.w;
            xr[64 * j] = v[j]; t += (v[j].x + v[j].y) + (v[j].z + v[j].w); }
        if (l + 1 < DEPTH) {
            const float mean2 = wave_sum(t) * (1.f / DM); float t2 = 0.f;
#pragma unroll
            for (int j = 0; j < 4; ++j) { v[j] = v[j] - mean2; t2 += (v[j].x * v[j].x + v[j].y * v[j].y) + (v[j].z * v[j].z + v[j].w * v[j].w); }
            const float rstd2 = 1.f / sqrtf(wave_sum(t2) * (1.f / DM) + LN_EPS);
            const float* modb = F.mod() + (size_t)((l + 1) * NB + (m >> 11)) * ADAC;
            unsigned long long* o8 = (unsigned long long*)(F.H() + (size_t)m * DM) + F.lane;
#pragma unroll
            for (int j = 0; j < 4; ++j) { const f32x4 sh = *((const f32x4*)modb + F.lane + 64 * j), sc = *((const f32x4*)(modb + DM) + F.lane + 64 * j);
                const float a = v[j].x * rstd2 * (1.f + sc.x) + sh.x, b = v[j].y * rstd2 * (1.f + sc.y) + sh.y, c = v[j].z * rstd2 * (1.f + sc.z) + sh.z, d = v[j].w * rstd2 * (1.f + sc.w) + sh.w;
                o8[64 * j] = (unsigned long long)pk2(a, b) | ((unsigned long long)pk2(c, d) << 32); }
        }
    }
}

__device__ __forceinline__ void hgrn_naive_unit(Ctx& F, int l, int bh) {
    const int b = bh >> 3, h = bh & 7, tid = F.tid;
    const bf16* Pb = F.P() + (size_t)b * SEQ * INC;
    LAS float* sq = (LAS float*)F.lds;
    LAS float* sf = sq + 16 * 128;
    LAS float* sk = sf + 16 * 128;
    LAS float* so = sk + 16 * 128;
    LAS float* srs = so + 16 * 128;
    const bool act = tid < 128;
    const int ch = h * 128 + (tid & 127);
    const float ng = F.hg_norm_g()[l * 128 + (tid & 127)];
    for (int pass = 1; pass >= 0; --pass) {
        float S[128];
#pragma unroll
        for (int d = 0; d < 128; ++d) S[d] = 0.f;
        const float lbv = F.lb()[(pass * 4 + l) * 1024 + ch];
        const int zc = pass ? C_ZBW : C_ZFW;
        for (int c = 0; c < SEQ / 16; ++c) {
            if (act) {
#pragma unroll 4
                for (int i = 0; i < 16; ++i) { const int tt = c * 16 + i, tok = pass ? (SEQ - 1 - tt) : tt; const bf16* row = Pb + (size_t)tok * INC;
                    const float q = bf2f(row[C_QH + ch]), z = bf2f(row[zc + ch]);
                    const float f = lbv + (1.f - lbv) * sigmoidf_(z);
                    sq[i * 128 + tid] = q; sf[i * 128 + tid] = f; sk[i * 128 + tid] = 1.f - f; }
            }
            __syncthreads();
            if (act) {
                for (int i = 0; i < 16; ++i) { const int tt = c * 16 + i, tok = pass ? (SEQ - 1 - tt) : tt; const bf16* row = Pb + (size_t)tok * INC;
                    const float vt = bf2f(row[C_IH + ch]); float o = 0.f;
#pragma unroll
                    for (int d = 0; d < 128; ++d) { S[d] = sf[i * 128 + d] * S[d] + sk[i * 128 + d] * vt; o += sq[i * 128 + d] * S[d]; }
                    float* op = F.obuf() + ((size_t)b * SEQ + tok) * 1024 + ch;
                    if (pass) *op = o; else so[i * 128 + tid] = o + *op; }
            }
            __syncthreads();
            if (pass == 0) {
                if (tid < 16) { float ss = 0.f; for (int d = 0; d < 128; ++d) { const float v = so[tid * 128 + d]; ss += v * v; } srs[tid] = 1.f / sqrtf(ss * (1.f / 128.f) + RMS_EPS); }
                __syncthreads();
                if (act) { for (int i = 0; i < 16; ++i) { const int tok = c * 16 + i; const bf16* row = Pb + (size_t)tok * INC;
                        const float g = bf2f(row[C_GH + ch]); const float y = so[i * 128 + tid] * srs[i] * ng * (g * sigmoidf_(g));
                        F.Y()[((size_t)b * SEQ + tok) * MIXW + ch] = (bf16)f2bf(y); } }
                __syncthreads();
            }
        }
    }
}
__device__ __forceinline__ void na_naive_items(Ctx& F, int l) {
    LAS float* sp = (LAS float*)(F.lds + 65536) + F.wave * 128;
    const int lane = F.lane;
    for (int it0 = blockIdx.x * 8; it0 < MTOK * 16; it0 += gridDim.x * 8) {
        const int it = it0 + F.wave;
        const int tokq = it >> 4, h = it & 15, b = tokq >> 11, r = (tokq >> 6) & 31, col = tokq & 63;
        const int rs = min(max(r - 4, 0), 24), cs = min(max(col - 8, 0), 48);
        const bf16* qrow = F.P() + (size_t)tokq * INC + C_QN + h * 64;
        float s2[2];
#pragma unroll
        for (int e = 0; e < 2; ++e) { const int kk = lane + 64 * e, kr = kk >> 4, kc = kk & 15; const int tokk = b * SEQ + (rs + kr) * 64 + cs + kc;
            const bf16* krow = F.P() + (size_t)tokk * INC + C_KN + h * 64; float dot = 0.f;
#pragma unroll
            for (int d8 = 0; d8 < 8; ++d8) { const v4u qa = *(const v4u*)(qrow + d8 * 8), ka = *(const v4u*)(krow + d8 * 8);
#pragma unroll
                for (int w = 0; w < 4; ++w) { dot += __uint_as_float(qa[w] << 16) * __uint_as_float(ka[w] << 16) + __uint_as_float(qa[w] & 0xffff0000u) * __uint_as_float(ka[w] & 0xffff0000u); } }
            const float bias = F.rpb()[(((size_t)l * 16 + h) * 15 + (rs + kr - r + 7)) * 31 + (cs + kc - col + 15)];
            s2[e] = dot * 0.125f + bias; }
        const float mx = wave_max(fmaxf(s2[0], s2[1]));
        const float p0 = __expf(s2[0] - mx), p1 = __expf(s2[1] - mx);
        const float sum = wave_sum(p0 + p1);
        sp[lane] = p0; sp[lane + 64] = p1;
        asm volatile("s_waitcnt lgkmcnt(0)" ::: "memory");
        float o = 0.f;
        for (int kk = 0; kk < 128; ++kk) { const int kr = kk >> 4, kc = kk & 15; const int tokk = b * SEQ + (rs + kr) * 64 + cs + kc;
            o += sp[kk] * bf2f(F.P()[(size_t)tokk * INC + C_VN + h * 64 + lane]); }
        const float g = bf2f(F.P()[(size_t)tokq * INC + C_GN + h * 64 + lane]);
        F.Y()[(size_t)tokq * MIXW + 1024 + h * 64 + lane] = (bf16)f2bf(o / sum * (g * sigmoidf_(g)));
        asm volatile("s_waitcnt lgkmcnt(0)" ::: "memory");
    }
}
__device__ __forceinline__ void phase_mix_naive(Ctx& F, int l) {
    for (int u = blockIdx.x; u < 64; u += gridDim.x) hgrn_naive_unit(F, l, u);
    __syncthreads();
    na_naive_items(F, l);
}

__global__ void __launch_bounds__(512, 2) fwd_kernel(Args a) {
    extern __shared__ __attribute__((aligned(16))) unsigned char lds[];
    Ctx F;
    F.lds = (LAS unsigned char*)lds; F.tid = threadIdx.x; F.lane = F.tid & 63; F.wave = __builtin_amdgcn_readfirstlane(F.tid >> 6);
    F.a = &a;
    for (int ph = a.ph_lo; ph < a.ph_hi; ++ph) {
        { int t_ = threadIdx.x; asm volatile("" : "+v"(t_)); F.tid = t_; F.lane = t_ & 63; F.wave = __builtin_amdgcn_readfirstlane(t_ >> 6); }
        if (ph == 0) phase_prologue(F);
        else if (ph == 1) phase_ln0(F);
        else {
            const int l = (ph - 2) >> 2, k = (ph - 2) & 3;
            if (k == 0) {
                pg8::Gemm g{F.H(), F.wt_in() + (size_t)l * INC * DM, MTOK, INC, DM}; pg8::StaticOrder S; S.init(MTOK, INC, gridDim.x, (int)blockIdx.x);
                pg8::EpiBf16<0> E{F.P(), INC, nullptr, 0, 0, 1.f};
                pg8::gemm_phase<pg8::EpiBf16<0>, pg8::StaticOrder, true, true>(F.lds, g, S, E);
            } else if (k == 1) {
                phase_mix_naive(F, l);
            } else if (k == 2) {
                pg8::Gemm g{F.Y(), F.wt_out() + (size_t)l * DM * MIXW, MTOK, DM, MIXW}; pg8::StaticOrder S; S.init(MTOK, DM, gridDim.x, (int)blockIdx.x);
                EpiZ E{l == 0 ? F.x() : F.out(), F.out(), F.mod() + (size_t)l * NB * ADAC + 2 * DM};
                pg8::gemm_phase<EpiZ, pg8::StaticOrder, false, true>(F.lds, g, S, E);
            } else {
                phase_ln(F, l);
            }
        }
        if (ph + 1 < a.ph_hi) { __syncthreads(); cg::this_grid().sync(); }
    }
}

__global__ void fill_kernel(float* o, int n, float v) { for (int i = blockIdx.x * blockDim.x + threadIdx.x; i < n; i += gridDim.x * blockDim.x) o[i] = v; }

extern "C" void kernel_launch(void* const* d_in, const int* in_sizes, int n_in, void* d_out, int out_size, void* d_ws, size_t ws_size, hipStream_t stream) {
    static int grid = 0;
    if (grid == 0) {
        int dev = 0, cus = 0;
        if (hipGetDevice(&dev) != hipSuccess || hipDeviceGetAttribute(&cus, hipDeviceAttributeMultiprocessorCount, dev) != hipSuccess) { grid = -1; return; }
        if (hipFuncSetAttribute((const void*)fwd_kernel, hipFuncAttributeMaxDynamicSharedMemorySize, LDS_BYTES) != hipSuccess) { grid = -1; return; }
        int per_cu = 0;
        if (hipOccupancyMaxActiveBlocksPerMultiprocessor(&per_cu, (const void*)fwd_kernel, 512, LDS_BYTES) != hipSuccess || per_cu < 1) { fprintf(stderr, "occupancy query: %d\n", per_cu); }
        (void)hipGetLastError();
        grid = cus * (per_cu < 1 ? 1 : (per_cu > 1 ? 1 : per_cu));
    }
    if (grid < 0) return;
    if (n_in != 11 || out_size != MTOK * DM || ws_size < WS_END) { fill_kernel<<<256, 256, 0, stream>>>((float*)d_out, out_size, ws_size < WS_END ? 12345.0f : 54321.0f); return; }
    Args a{};
    for (int i = 0; i < 11; ++i) a.in[i] = (const float*)d_in[i];
    a.out = (float*)d_out; a.ws = (unsigned char*)d_ws;
    a.ph_lo = 0; a.ph_hi = NPHASE; a.coop = 1;
    void* kargs[] = {&a};
    hipError_t e = hipLaunchCooperativeKernel((const void*)fwd_kernel, dim3(grid), dim3(512), kargs, LDS_BYTES, stream);
    if (e != hipSuccess) fprintf(stderr, "cooperative launch failed: %s (grid %d)\n", hipGetErrorString(e), grid);
}
```

```cpp
#include <hip/hip_runtime.h>
#include <hip/hip_cooperative_groups.h>
#include <cstdio>
#include <cstdint>
namespace pg8 {
#define PG8_LAS __attribute__((address_space(3)))
typedef unsigned short bf16_t;
typedef short bf16x8 __attribute__((ext_vector_type(8)));
typedef float f32x4 __attribute__((ext_vector_type(4)));
typedef unsigned u32x4 __attribute__((ext_vector_type(4)));
constexpr int BM = 256, BK = 64, HALF = 128, HTB = HALF * BK * 2  , STAGE_BYTES = 8 * HTB, NXCD = 8, WGM = 8;

__host__ __device__ __forceinline__ int lds_byte(int r, int c) { const int st = (r >> 4) * 2 + (c >> 5), rr = r & 15, cc = c & 31, ob = rr * 64 + cc * 2; return st * 1024 + (ob ^ (((ob >> 9) & 1) << 5)); }
__host__ __device__ __forceinline__ void stage_rc(int b, int& R, int& C) { const int st = b / 1024, sb = b % 1024, swz = sb ^ (((sb >> 9) & 1) << 5); R = (st >> 1) * 16 + swz / 64; C = (st & 1) * 32 + (swz % 64) / 2; }
__host__ __device__ __forceinline__ int perm32(int rho) { const int n = rho >> 4, i = rho & 15; return 8 * (i >> 2) + 4 * n + (i & 3); }

struct Unit { int pm, pn; };
struct Gemm { const bf16_t* A; const bf16_t* Bt; int M, N, K; };

struct StaticOrder {
    int nM, nN, nwg, G, c;
    __host__ __device__ void init(int M, int N, int G_, int c_) { nM = M / BM; nN = N / BM; nwg = nM * nN; G = G_; c = c_; }
    __host__ __device__ bool next(int i, Unit& u) const {
        const long L = (long)i * G + c; if (L >= nwg) return false;
        int wgid = (int)L; { const int q = nwg / NXCD, r = nwg % NXCD, xcd = wgid % NXCD, off = wgid / NXCD; wgid = (xcd < r ? xcd * (q + 1) : r * (q + 1) + (xcd - r) * q) + off; }
        const int nig = WGM * nN, gid = wgid / nig, fm = gid * WGM, gsz = (nM - fm) < WGM ? (nM - fm) : WGM;
        u.pm = fm + ((wgid % nig) % gsz); u.pn = (wgid % nig) / gsz; return true;
    }
    __device__ __forceinline__ void a_ready(const Unit&) const {}
    __device__ __forceinline__ void done(const Unit&) const {}
};

__device__ __forceinline__ unsigned cvt_pk_bf16(float lo, float hi) { unsigned r; asm volatile("v_cvt_pk_bf16_f32 %0, %1, %2" : "=v"(r) : "v"(lo), "v"(hi)); return r; }
typedef float f32x2 __attribute__((ext_vector_type(2)));
__device__ __forceinline__ f32x2 gelu_pk(f32x2 v) {
    const f32x2 av = __builtin_elementwise_abs(v), d = av * 0.2316418882f + 1.0f;
    f32x2 t; t.x = __builtin_amdgcn_rcpf(d.x); t.y = __builtin_amdgcn_rcpf(d.y);
    f32x2 q = t * 0.5307027145f + (-0.7265760135f); q = q * t + 0.7107068705f; q = q * t + (-0.142248368f); q = q * t + 0.127414796f; q = q * t;
    const f32x2 s = (v * v) * (-0.72134752044f);
    f32x2 e; e.x = __builtin_amdgcn_exp2f(s.x); e.y = __builtin_amdgcn_exp2f(s.y);
    const f32x2 m = v * (q * e), r = v - m;
    f32x2 o; o.x = v.x < 0.f ? m.x : r.x; o.y = v.y < 0.f ? m.y : r.y; return o;
}

template <int ACT  > struct EpiBf16 {
    static constexpr bool PERM = true, AFTER_DRAIN = false; static_assert(ACT == 0 || ACT == 1, "EpiBf16: ACT is 0 (none) or 1 (gelu_pk)");
    bf16_t* O; int ldc; const float* bias; int split_cols; size_t split_stride; float scale0;
    __device__ __forceinline__ void operator()(const f32x4 (&acc)[2][2][4][2], const Unit& u, int wr, int wc, int fr, int fq) const {
        const int row0 = u.pm * BM + wr * 64 + fr; int colt = u.pn * BM; bf16_t* base = O;
        float sc = 1.f; if (split_cols) { const int t = colt / split_cols; base += (size_t)t * split_stride; colt -= t * split_cols; if (t == 0) sc = scale0; }
        const int col0 = colt + wc * 32 + 8 * fq, bcol0 = u.pn * BM + wc * 32 + 8 * fq;
        f32x4 bv[2][2];
#pragma unroll
        for (int bj = 0; bj < 2; ++bj)
#pragma unroll
            for (int n = 0; n < 2; ++n) bv[bj][n] = bias ? *(const f32x4*)(bias + bcol0 + bj * HALF + 4 * n) : (f32x4){0.f, 0.f, 0.f, 0.f};
#pragma unroll
        for (int ai = 0; ai < 2; ++ai)
#pragma unroll
            for (int m = 0; m < 4; ++m) { bf16_t* rowp = base + (size_t)(row0 + ai * HALF + m * 16) * ldc + col0;
#pragma unroll
                for (int bj = 0; bj < 2; ++bj) { f32x4 v0 = acc[ai][bj][m][0] + bv[bj][0], v1 = acc[ai][bj][m][1] + bv[bj][1];
                    if (ACT == 1) { f32x2 a = gelu_pk((f32x2){v0[0], v0[1]}), b = gelu_pk((f32x2){v0[2], v0[3]}), c = gelu_pk((f32x2){v1[0], v1[1]}), d = gelu_pk((f32x2){v1[2], v1[3]});
                        v0 = (f32x4){a.x, a.y, b.x, b.y}; v1 = (f32x4){c.x, c.y, d.x, d.y}; }
                    v0 = v0 * sc; v1 = v1 * sc; u32x4 w; w.x = cvt_pk_bf16(v0[0], v0[1]); w.y = cvt_pk_bf16(v0[2], v0[3]); w.z = cvt_pk_bf16(v1[0], v1[1]); w.w = cvt_pk_bf16(v1[2], v1[3]);
                    *(u32x4*)(rowp + bj * HALF) = w; } }
    }
};

struct PanelStats {
    unsigned* xbuf;
    unsigned* cnt;
    unsigned* tmo;
    int ntn; float eps;
    unsigned code;
    __device__ __forceinline__ bool run(const f32x4 (&v)[2][2][4][2], const Unit& u, int wr, int wc, int fr, int fq, PG8_LAS unsigned char* lds, int wid, int lane) const {
        typedef float f32x2v __attribute__((ext_vector_type(2)));
        PG8_LAS f32x2v* P = (PG8_LAS f32x2v*)lds;
        PG8_LAS f32x2v* S = (PG8_LAS f32x2v*)(lds + 8192);
        PG8_LAS unsigned* flag = (PG8_LAS unsigned*)(lds + 8192 + 2048);
#pragma unroll
        for (int ai = 0; ai < 2; ++ai)
#pragma unroll
            for (int m = 0; m < 4; ++m) {
                float s = 0.f;
#pragma unroll
                for (int bj = 0; bj < 2; ++bj)
#pragma unroll
                    for (int n = 0; n < 2; ++n) { const f32x4 x = v[ai][bj][m][n]; s += (x[0] + x[1]) + (x[2] + x[3]); }
                s += __shfl_xor(s, 16); s += __shfl_xor(s, 32);
                const float mw = s * (1.0f / 64.0f); float q = 0.f;
#pragma unroll
                for (int bj = 0; bj < 2; ++bj)
#pragma unroll
                    for (int n = 0; n < 2; ++n) { const f32x4 d = v[ai][bj][m][n] - mw; q += (d[0] * d[0] + d[1] * d[1]) + (d[2] * d[2] + d[3] * d[3]); }
                q += __shfl_xor(q, 16); q += __shfl_xor(q, 32);
                if (fq == 0) P[(ai * HALF + wr * 64 + m * 16 + fr) * 4 + wc] = (f32x2v){mw, q};
            }
        asm volatile("s_waitcnt lgkmcnt(0)" ::: "memory"); __builtin_amdgcn_s_barrier(); asm volatile("" ::: "memory");
#if defined(BROKEN_EXCHANGE_NO_WAIT)
#warning BROKEN CONTROL BUILD: the row-statistics exchange does not wait; results are wrong by design
        if (blockIdx.x >= 64) { const long long t0_ = clock64(); while (clock64() - t0_ < 60000) __builtin_amdgcn_s_sleep(8); }
#endif
        const int row = wid * 32 + (lane & 31);
        if (lane < 32) {
            const f32x2v a = P[row * 4 + 0], b = P[row * 4 + 1], c = P[row * 4 + 2], d = P[row * 4 + 3];
            const float mt = (a.x + b.x + c.x + d.x) * 0.25f;
            const float da = a.x - mt, db = b.x - mt, dc = c.x - mt, dd = d.x - mt;
            const float m2 = (a.y + b.y) + (c.y + d.y) + 64.0f * ((da * da + db * db) + (dc * dc + dd * dd));
            unsigned long long* slot = (unsigned long long*)xbuf + ((size_t)(u.pm * BM + row) * 4 + u.pn);
            __hip_atomic_store(slot, ((unsigned long long)__float_as_uint(m2) << 32) | __float_as_uint(mt), __ATOMIC_RELAXED, __HIP_MEMORY_SCOPE_AGENT);
        }
        asm volatile("s_waitcnt vmcnt(0)" ::: "memory");
        if (lane == 0) __hip_atomic_fetch_add(cnt + 64 * u.pm, 1u, __ATOMIC_RELAXED, __HIP_MEMORY_SCOPE_AGENT);
        if (wid == 0) {
            bool dead = false; const unsigned long long t0 = __builtin_amdgcn_s_memrealtime(); const unsigned want = 8u * (unsigned)ntn;
            for (;;) {
#if defined(BROKEN_EXCHANGE_NO_WAIT)
                break;
#endif
                if ((unsigned)__builtin_amdgcn_readfirstlane(__hip_atomic_load(cnt + 64 * u.pm, __ATOMIC_RELAXED, __HIP_MEMORY_SCOPE_AGENT)) >= want) break;
                if (__builtin_amdgcn_s_memrealtime() - t0 > 2000000ull) {
                    if (lane == 0) { unsigned expect = 0u; __hip_atomic_compare_exchange_strong(tmo + 1, &expect, code | (unsigned)(u.pm & 0xff), __ATOMIC_RELAXED, __ATOMIC_RELAXED, __HIP_MEMORY_SCOPE_AGENT);
                                     __hip_atomic_store(tmo, 1u, __ATOMIC_RELAXED, __HIP_MEMORY_SCOPE_AGENT); }
                    dead = true; break; }
                __builtin_amdgcn_s_sleep(2);
            }
            __builtin_amdgcn_fence(__ATOMIC_ACQUIRE, "agent");
            if (lane == 0) flag[0] = dead ? 1u : 0u;
        }
        asm volatile("s_waitcnt vmcnt(0) lgkmcnt(0)" ::: "memory"); __builtin_amdgcn_s_barrier(); asm volatile("" ::: "memory");
        const bool bad = flag[0] != 0u;
        if (lane < 32) {
            const unsigned long long* slot = (const unsigned long long*)xbuf + (size_t)(u.pm * BM + row) * 4; float mt[4], m2[4]; float ms = 0.f;
#pragma unroll
            for (int t = 0; t < 4; ++t) { if (t < ntn) { const unsigned long long w = __hip_atomic_load(slot + t, __ATOMIC_RELAXED, __HIP_MEMORY_SCOPE_AGENT); mt[t] = __uint_as_float((unsigned)w); m2[t] = __uint_as_float((unsigned)(w >> 32)); } else { mt[t] = 0.f; m2[t] = 0.f; } ms += mt[t]; }
            const float mean = ms / (float)ntn; float q = 0.f;
#pragma unroll
            for (int t = 0; t < 4; ++t) if (t < ntn) { const float dm = mt[t] - mean; q += m2[t] + 256.0f * dm * dm; }
            S[row] = (f32x2v){mean, 1.0f / sqrtf(q / (256.0f * (float)ntn) + eps)};
        }
        asm volatile("s_waitcnt lgkmcnt(0)" ::: "memory"); __builtin_amdgcn_s_barrier(); asm volatile("" ::: "memory");
        return bad;
    }
};
struct EpiLnRes {
    static constexpr bool PERM = false, AFTER_DRAIN = true;
    const float* base; float* out; int ldc; const float* bias; PanelStats st; unsigned poison;
    __device__ __forceinline__ void fused(f32x4 (&acc)[2][2][4][2], const Unit& u, int wr, int wc, int fr, int fq, PG8_LAS unsigned char* lds, int wid, int lane) const {
        typedef float f32x2v __attribute__((ext_vector_type(2)));
        const PG8_LAS f32x2v* S = (const PG8_LAS f32x2v*)(lds + 8192);
        const int col0 = u.pn * BM + wc * 32 + 4 * fq;
#pragma unroll
        for (int bj = 0; bj < 2; ++bj)
#pragma unroll
            for (int n = 0; n < 2; ++n) { const f32x4 bv = bias ? *(const f32x4*)(bias + col0 + bj * HALF + n * 16) : (f32x4){0.f, 0.f, 0.f, 0.f};
#pragma unroll
                for (int ai = 0; ai < 2; ++ai)
#pragma unroll
                    for (int m = 0; m < 4; ++m) acc[ai][bj][m][n] += bv; }
        f32x4 pre[4][2][2];
#pragma unroll
        for (int m = 0; m < 4; ++m) { const size_t off = (size_t)(u.pm * BM + wr * 64 + m * 16 + fr) * ldc + col0;
#pragma unroll
            for (int bj = 0; bj < 2; ++bj)
#pragma unroll
                for (int n = 0; n < 2; ++n) pre[m][bj][n] = *(const f32x4*)(base + off + bj * HALF + n * 16); }
        const bool bad = st.run(acc, u, wr, wc, fr, fq, lds, wid, lane) || poison != 0u;
        const float qnan = __builtin_nanf("");
#pragma unroll
        for (int ai = 0; ai < 2; ++ai)
#pragma unroll
            for (int m = 0; m < 4; ++m) { const int r = ai * HALF + wr * 64 + m * 16 + fr; const f32x2v sr = S[r]; const size_t off = (size_t)(u.pm * BM + r) * ldc + col0;
#pragma unroll
                for (int bj = 0; bj < 2; ++bj)
#pragma unroll
                    for (int n = 0; n < 2; ++n) { const f32x4 bs = ai == 0 ? pre[m][bj][n] : *(const f32x4*)(base + off + bj * HALF + n * 16); f32x4 o = bs + (acc[ai][bj][m][n] - sr.x) * sr.y;
                        if (bad) o = (f32x4){qnan, qnan, qnan, qnan}; *(f32x4*)(out + off + bj * HALF + n * 16) = o; }
                if (m & 1) asm volatile("" ::: "memory"); }
    }
};
struct EpiLnResLn {
    static constexpr bool PERM = false, AFTER_DRAIN = true;
    const float* base; float* out; bf16_t* xn; int ldc; const float* bias; PanelStats st1, st2; unsigned poison;
    __device__ __forceinline__ void fused(f32x4 (&acc)[2][2][4][2], const Unit& u, int wr, int wc, int fr, int fq, PG8_LAS unsigned char* lds, int wid, int lane) const {
        typedef float f32x2v __attribute__((ext_vector_type(2))); typedef unsigned u32x2v __attribute__((ext_vector_type(2)));
        const PG8_LAS f32x2v* S = (const PG8_LAS f32x2v*)(lds + 8192);
        const int col0 = u.pn * BM + wc * 32 + 4 * fq;
#pragma unroll
        for (int bj = 0; bj < 2; ++bj)
#pragma unroll
            for (int n = 0; n < 2; ++n) { const f32x4 bv = bias ? *(const f32x4*)(bias + col0 + bj * HALF + n * 16) : (f32x4){0.f, 0.f, 0.f, 0.f};
#pragma unroll
                for (int ai = 0; ai < 2; ++ai)
#pragma unroll
                    for (int m = 0; m < 4; ++m) acc[ai][bj][m][n] += bv; }
        bool bad = st1.run(acc, u, wr, wc, fr, fq, lds, wid, lane) || poison != 0u;
        const float qnan = __builtin_nanf("");
#pragma unroll
        for (int ai = 0; ai < 2; ++ai)
#pragma unroll
            for (int m = 0; m < 4; ++m) { const int r = ai * HALF + wr * 64 + m * 16 + fr; const f32x2v sr = S[r]; const size_t off = (size_t)(u.pm * BM + r) * ldc + col0;
#pragma unroll
                for (int bj = 0; bj < 2; ++bj)
#pragma unroll
                    for (int n = 0; n < 2; ++n) { const f32x4 bs = *(const f32x4*)(base + off + bj * HALF + n * 16); acc[ai][bj][m][n] = bs + (acc[ai][bj][m][n] - sr.x) * sr.y; }
                asm volatile("" : "+v"(acc[ai][0][m][0]), "+v"(acc[ai][0][m][1]), "+v"(acc[ai][1][m][0]), "+v"(acc[ai][1][m][1]));
                if (m & 1) asm volatile("" ::: "memory"); }
        const bool bad1 = bad;
        bad = st2.run(acc, u, wr, wc, fr, fq, lds, wid, lane) || bad;
#pragma unroll
        for (int ai = 0; ai < 2; ++ai)
#pragma unroll
            for (int m = 0; m < 4; ++m) { const int r = ai * HALF + wr * 64 + m * 16 + fr; const f32x2v sr = S[r]; const size_t off = (size_t)(u.pm * BM + r) * ldc + col0;
#pragma unroll
                for (int bj = 0; bj < 2; ++bj)
#pragma unroll
                    for (int n = 0; n < 2; ++n) { const f32x4 x1 = acc[ai][bj][m][n]; *(f32x4*)(out + off + bj * HALF + n * 16) = bad1 ? (f32x4){qnan, qnan, qnan, qnan} : x1;
                        const f32x4 o = (x1 - sr.x) * sr.y; u32x2v w; w.x = cvt_pk_bf16(o[0], o[1]); w.y = cvt_pk_bf16(o[2], o[3]);
                        if (bad) { w.x = 0x7fc07fc0u; w.y = 0x7fc07fc0u; } *(u32x2v*)(xn + off + bj * HALF + n * 16) = w; }
                asm volatile("" ::: "memory"); }
    }
};

template <class Epi, class Sched, bool ALIGN_EPI = false, bool SP2 = false>
__device__ __forceinline__ void gemm_phase(PG8_LAS unsigned char* lds, const Gemm g, const Sched& S, const Epi& E) {
    int tid_ = threadIdx.x; asm volatile("" : "+v"(tid_)); const int tid = tid_, wid = __builtin_amdgcn_readfirstlane(tid >> 6), lane = tid & 63, wr = wid >> 2, wc = wid & 3, fr = lane & 15, fq = lane >> 4;
    const int K = g.K, nt = K / BK;
    unsigned voffA[2], voffB[2];
#pragma unroll
    for (int i = 0; i < 2; ++i) { int R, C; stage_rc(tid * 16 + i * 8192, R, C); const int Rb = Epi::PERM ? ((R & ~31) + perm32(R & 31)) : R;
        voffA[i] = (unsigned)(R * K + C) * 2u; voffB[i] = (unsigned)(Rb * K + C) * 2u; }
    const size_t kstep = (size_t)(BK * 2);
    const size_t hstep = (size_t)HALF * K * 2;
    const size_t tstep = 2 * hstep;
    const unsigned ldsw = (unsigned)wid * 1024u;
    const int aoff = lds_byte(wr * 64 + fr, fq * 8), boff = lds_byte(wc * 32 + fr, fq * 8);
#define PG8_SA(b, h) (((b) * 2 + (h)) * HTB)
#define PG8_SB(b, h) ((4 + (b) * 2 + (h)) * HTB)
#define PG8_STAGE(bufoff, gbase, voff) do { _Pragma("unroll") for (int _i = 0; _i < 2; ++_i) \
        __builtin_amdgcn_global_load_lds((const unsigned*)((const char*)(gbase) + (voff)[_i]), (PG8_LAS unsigned*)(lds + (bufoff) + ldsw + _i * 8192), 16, 0, 0); } while (0)
#define PG8_LDA(dst, b, h) do { _Pragma("unroll") for (int m = 0; m < 4; ++m) _Pragma("unroll") for (int k = 0; k < 2; ++k) dst[m][k] = *(const PG8_LAS bf16x8*)(lds + PG8_SA(b, h) + aoff + m * 2048 + k * 1024); } while (0)
#define PG8_LDB(dst, b, h) do { _Pragma("unroll") for (int n = 0; n < 2; ++n) _Pragma("unroll") for (int k = 0; k < 2; ++k) dst[n][k] = *(const PG8_LAS bf16x8*)(lds + PG8_SB(b, h) + boff + n * 2048 + k * 1024); } while (0)
#define PG8_MMA(ai, bj, At, Bt) do { __builtin_amdgcn_s_setprio(1); _Pragma("unroll") for (int m = 0; m < 4; ++m) _Pragma("unroll") for (int n = 0; n < 2; ++n) _Pragma("unroll") for (int k = 0; k < 2; ++k) \
        acc[ai][bj][m][n] = __builtin_amdgcn_mfma_f32_16x16x32_bf16(Bt[n][k], At[m][k], acc[ai][bj][m][n], 0, 0, 0); __builtin_amdgcn_s_setprio(0); } while (0)
#define PG8_WAIT_V(n) asm volatile("s_waitcnt vmcnt(" #n ")" ::: "memory")
#define PG8_WAIT_L(n) asm volatile("s_waitcnt lgkmcnt(" #n ")" ::: "memory")
#define PG8_BAR __builtin_amdgcn_s_barrier()
#define PG8_SCHED __builtin_amdgcn_sched_barrier(0)
    Unit cur, nxt; int ui = 0;
    if (!S.next(0, cur)) return;
    f32x4 acc[2][2][4][2];
#pragma unroll
    for (int a = 0; a < 2; ++a)
#pragma unroll
        for (int b = 0; b < 2; ++b)
#pragma unroll
            for (int m = 0; m < 4; ++m)
#pragma unroll
                for (int n = 0; n < 2; ++n) acc[a][b][m][n] = (f32x4){0.f, 0.f, 0.f, 0.f};
    bf16x8 At[4][2], B0[2][2], B1[2][2];
    const char* cA = (const char*)g.A + (size_t)cur.pm * tstep; const char* cB = (const char*)g.Bt + (size_t)cur.pn * tstep;
    S.a_ready(cur);
    if constexpr (SP2) {
        PG8_STAGE(PG8_SB(0, 0), cB, voffB); PG8_STAGE(PG8_SB(0, 1), cB + hstep, voffB); PG8_STAGE(PG8_SA(0, 0), cA, voffA); PG8_STAGE(PG8_SA(0, 1), cA + hstep, voffA);
        if (wr == 1) PG8_BAR;
        PG8_WAIT_V(2); PG8_BAR;
        PG8_STAGE(PG8_SB(1, 0), cB + kstep, voffB); PG8_STAGE(PG8_SA(1, 0), cA + kstep, voffA); PG8_STAGE(PG8_SB(1, 1), cB + hstep + kstep, voffB);
        PG8_WAIT_V(6); PG8_BAR;
    } else {
        PG8_STAGE(PG8_SB(0, 0), cB, voffB); PG8_STAGE(PG8_SA(0, 0), cA, voffA); PG8_STAGE(PG8_SB(0, 1), cB + hstep, voffB); PG8_STAGE(PG8_SA(0, 1), cA + hstep, voffA);
        if (wr == 1) PG8_BAR;
        PG8_WAIT_V(4); PG8_BAR;
        PG8_STAGE(PG8_SB(1, 0), cB + kstep, voffB); PG8_STAGE(PG8_SA(1, 0), cA + kstep, voffA); PG8_STAGE(PG8_SB(1, 1), cB + hstep + kstep, voffB);
        PG8_WAIT_V(6); PG8_BAR;
    }
    for (;;) {
        const bool has_next = S.next(ui + 1, nxt);
        const char* nA = has_next ? (const char*)g.A + (size_t)nxt.pm * tstep : cA; const char* nB = has_next ? (const char*)g.Bt + (size_t)nxt.pn * tstep : cB;
        for (int t = 0; t < nt; t += 2) {
            const bool last = (t == nt - 2);
            const char* a1 = cA + (size_t)(t + 1) * kstep;
            const char* a2 = last ? nA : cA + (size_t)(t + 2) * kstep; const char* b2 = last ? nB : cB + (size_t)(t + 2) * kstep;
            const char* a3 = a2 + kstep; const char* b3 = b2 + kstep;
            if (last && has_next) S.a_ready(nxt);
            if constexpr (SP2) {
            PG8_LDB(B0, 0, 0); PG8_LDB(B1, 0, 1); PG8_SCHED; PG8_LDA(At, 0, 0); PG8_STAGE(PG8_SA(1, 1), a1 + hstep, voffA);
            PG8_WAIT_V(8); PG8_WAIT_L(0); PG8_BAR; PG8_MMA(0, 0, At, B0); PG8_MMA(0, 1, At, B1); PG8_BAR; PG8_SCHED;
            PG8_LDA(At, 0, 1); PG8_STAGE(PG8_SB(0, 0), b2, voffB); PG8_STAGE(PG8_SB(0, 1), b2 + hstep, voffB); PG8_STAGE(PG8_SA(0, 0), a2, voffA);
            PG8_WAIT_V(8); PG8_WAIT_L(0); PG8_BAR; PG8_MMA(1, 0, At, B0); PG8_MMA(1, 1, At, B1); PG8_BAR; PG8_SCHED;
            PG8_LDB(B0, 1, 0); PG8_LDB(B1, 1, 1); PG8_SCHED; PG8_LDA(At, 1, 0); PG8_STAGE(PG8_SA(0, 1), a2 + hstep, voffA);
            PG8_WAIT_V(8); PG8_WAIT_L(0); PG8_BAR; PG8_MMA(0, 0, At, B0); PG8_MMA(0, 1, At, B1); PG8_BAR; PG8_SCHED;
            PG8_LDA(At, 1, 1); PG8_STAGE(PG8_SB(1, 0), b3, voffB); PG8_STAGE(PG8_SB(1, 1), b3 + hstep, voffB); PG8_STAGE(PG8_SA(1, 0), a3, voffA);
            PG8_WAIT_V(8); PG8_WAIT_L(0); PG8_BAR; PG8_MMA(1, 0, At, B0); PG8_MMA(1, 1, At, B1); PG8_BAR; PG8_SCHED;
            } else {
            PG8_LDB(B0, 0, 0); PG8_SCHED; PG8_LDA(At, 0, 0); PG8_STAGE(PG8_SA(1, 1), a1 + hstep, voffA);
            PG8_WAIT_L(8); PG8_BAR; PG8_WAIT_L(0); PG8_MMA(0, 0, At, B0); PG8_BAR; PG8_SCHED;
            PG8_LDB(B1, 0, 1); PG8_STAGE(PG8_SB(0, 0), b2, voffB);
            PG8_BAR; PG8_WAIT_L(0); PG8_MMA(0, 1, At, B1); PG8_BAR;
            PG8_LDA(At, 0, 1); PG8_STAGE(PG8_SA(0, 0), a2, voffA);
            PG8_BAR; PG8_WAIT_L(0); PG8_MMA(1, 0, At, B0); PG8_BAR; PG8_SCHED;
            PG8_STAGE(PG8_SB(0, 1), b2 + hstep, voffB);
            PG8_WAIT_V(6); PG8_BAR; PG8_MMA(1, 1, At, B1); PG8_BAR;
            PG8_LDB(B0, 1, 0); PG8_SCHED; PG8_LDA(At, 1, 0); PG8_STAGE(PG8_SA(0, 1), a2 + hstep, voffA);
            PG8_WAIT_L(8); PG8_BAR; PG8_WAIT_L(0); PG8_MMA(0, 0, At, B0); PG8_BAR; PG8_SCHED;
            PG8_LDB(B1, 1, 1); PG8_STAGE(PG8_SB(1, 0), b3, voffB);
            PG8_BAR; PG8_WAIT_L(0); PG8_MMA(0, 1, At, B1); PG8_BAR;
            PG8_LDA(At, 1, 1); PG8_STAGE(PG8_SA(1, 0), a3, voffA);
            PG8_BAR; PG8_WAIT_L(0); PG8_MMA(1, 0, At, B0); PG8_BAR; PG8_SCHED;
            PG8_STAGE(PG8_SB(1, 1), b3 + hstep, voffB);
            PG8_WAIT_V(6); PG8_BAR; PG8_MMA(1, 1, At, B1); PG8_BAR;
            }
        }
        if constexpr (ALIGN_EPI) { if (wr == 0) PG8_BAR; }
        if constexpr (!Epi::AFTER_DRAIN) { E(acc, cur, wr, wc, fr, fq); S.done(cur); }
        if (!has_next) break;
#pragma unroll
        for (int a = 0; a < 2; ++a)
#pragma unroll
            for (int b = 0; b < 2; ++b)
#pragma unroll
                for (int m = 0; m < 4; ++m)
#pragma unroll
                    for (int n = 0; n < 2; ++n) acc[a][b][m][n] = (f32x4){0.f, 0.f, 0.f, 0.f};
        cur = nxt; cA = nA; cB = nB; ++ui;
        if constexpr (ALIGN_EPI) { if (wr == 1) PG8_BAR; }
    }
    PG8_WAIT_V(0);
    if constexpr (!ALIGN_EPI) { if (wr == 0) PG8_BAR; }
    PG8_BAR;
    if constexpr (Epi::AFTER_DRAIN) { E.fused(acc, cur, wr, wc, fr, fq, lds, wid, lane); S.done(cur); }
#undef PG8_SA
#undef PG8_SB
#undef PG8_STAGE
#undef PG8_LDA
#undef PG8_LDB
#undef PG8_MMA
#undef PG8_WAIT_V
#undef PG8_WAIT_L
#undef PG8_BAR
#undef PG8_SCHED
}
}
namespace cg = cooperative_groups;
#define GAS __attribute__((address_space(1)))
#define LAS __attribute__((address_space(3)))
typedef unsigned short bf16;
typedef unsigned v4u __attribute__((ext_vector_type(4)));
typedef unsigned v2u __attribute__((ext_vector_type(2)));
typedef float f32x4 __attribute__((ext_vector_type(4)));
typedef short bf16x8 __attribute__((ext_vector_type(8)));

constexpr int NB = 8, SEQ = 2048, DM = 1024, DEPTH = 4, MTOK = NB * SEQ;
constexpr int INC = 9216, ADAC = 3072, MIXW = 2048;
constexpr int C_QH = 0, C_IH = 1024, C_ZFW = 2048, C_ZBW = 3072, C_GH = 4096, C_QN = 5120, C_KN = 6144, C_VN = 7168, C_GN = 8192;
constexpr float DN_ALPHA = 1.6817928305074290f;
constexpr float LN_EPS = 1e-5f, RMS_EPS = 1e-6f;

constexpr size_t MiB = 1u << 20;
constexpr size_t WS_CTL = 0, CTL_ZERO_BYTES = 1 * MiB;
constexpr size_t WS_MOD = 1 * MiB;
constexpr size_t WS_LB = 1 * MiB + 512 * 1024;
constexpr size_t WS_WTIN = 2 * MiB;
constexpr size_t WS_WTOUT = 74 * MiB;
constexpr size_t WS_H = 90 * MiB;
constexpr size_t WS_P = 122 * MiB;
constexpr size_t WS_Y = 410 * MiB;
constexpr size_t WS_OBUF = 474 * MiB;
constexpr size_t WS_OB2 = 538 * MiB;
constexpr size_t WS_END = 570 * MiB;
constexpr int CW_HG = 1024;

constexpr int LDS_BYTES = 147456;
constexpr int LDS_FLAG = 147456 - 64;
constexpr int NPHASE = 2 + 4 * DEPTH;

__device__ __forceinline__ float bf2f(bf16 v) { return __uint_as_float((unsigned)v << 16); }
__device__ __forceinline__ unsigned f2bf(float f) { unsigned u = __float_as_uint(f); return (u + 0x7fffu + ((u >> 16) & 1u)) >> 16; }
__device__ __forceinline__ unsigned pk2(float lo, float hi) { return f2bf(lo) | (f2bf(hi) << 16); }
__device__ __forceinline__ float wave_sum(float v) {
#pragma unroll
    for (int o = 1; o < 64; o <<= 1) v += __shfl_xor(v, o);
    return v;
}
__device__ __forceinline__ float wave_max(float v) {
#pragma unroll
    for (int o = 1; o < 64; o <<= 1) v = fmaxf(v, __shfl_xor(v, o));
    return v;
}
__device__ __forceinline__ float sigmoidf_(float z) { return 1.0f / (1.0f + __expf(-z)); }

struct Args { const float* in[11]; float* out; unsigned char* ws; int ph_lo, ph_hi, coop, pad; };

__device__ __forceinline__ void p0_transpose_item(const float* W, int K, int N, bf16* WT, LAS float* scr, int item, int lane) {
    const int nblk = N / 32, kb = item / nblk, nb = item % nblk, k0 = 64 * kb, n0 = 32 * nb;
#pragma unroll 8
    for (int i = 0; i < 32; ++i) { const int kk = 2 * i + (lane >> 5); scr[kk * 33 + (lane & 31)] = W[(size_t)(k0 + kk) * N + n0 + (lane & 31)]; }
    asm volatile("s_waitcnt lgkmcnt(0)" ::: "memory");
    const int c = lane & 7;
#pragma unroll
    for (int j = 0; j < 4; ++j) { const int n = (lane >> 3) + 8 * j; const LAS float* s = scr + (8 * c) * 33 + n;
        v4u o; o.x = pk2(s[0 * 33], s[1 * 33]); o.y = pk2(s[2 * 33], s[3 * 33]); o.z = pk2(s[4 * 33], s[5 * 33]); o.w = pk2(s[6 * 33], s[7 * 33]);
        *(v4u*)(WT + (size_t)(n0 + n) * K + k0 + 8 * c) = o; }
    asm volatile("s_waitcnt lgkmcnt(0)" ::: "memory");
}

struct EpiZ {
    static constexpr bool PERM = false, AFTER_DRAIN = false;
    const float* xin; float* out; const float* gate;
    __device__ __forceinline__ void operator()(const pg8::f32x4 (&acc)[2][2][4][2], const pg8::Unit& u, int wr, int wc, int fr, int fq) const {
        const int col0 = u.pn * 256 + wc * 32 + 4 * fq;
        const float* g = gate + (size_t)(u.pm >> 3) * ADAC;
#pragma unroll
        for (int ai = 0; ai < 2; ++ai)
#pragma unroll
            for (int m = 0; m < 4; ++m) { const size_t r = (size_t)u.pm * 256 + ai * 128 + wr * 64 + m * 16 + fr;
#pragma unroll
                for (int bj = 0; bj < 2; ++bj)
#pragma unroll
                    for (int n = 0; n < 2; ++n) { const int c = col0 + bj * 128 + n * 16;
                        const f32x4 g4 = *(const f32x4*)(g + c); const f32x4 xv = *(const f32x4*)(xin + r * DM + c);
                        const pg8::f32x4 av = acc[ai][bj][m][n];
                        f32x4 o; o.x = DN_ALPHA * xv.x + g4.x * av[0]; o.y = DN_ALPHA * xv.y + g4.y * av[1]; o.z = DN_ALPHA * xv.z + g4.z * av[2]; o.w = DN_ALPHA * xv.w + g4.w * av[3];
                        *(f32x4*)(out + r * DM + c) = o; } }
    }
};

struct Ctx {
    LAS unsigned char* lds; int tid, lane, wave;
    const Args* a;
    __device__ __forceinline__ const float* in(int k) const { return a->in[k]; }
    __device__ __forceinline__ unsigned char* wsp() const { return a->ws; }
#define CTXP(name, expr) __device__ __forceinline__ auto name() const { return expr; }
    CTXP(x, in(0)) CTXP(c, in(1)) CTXP(ada_w, in(2)) CTXP(ada_b, in(3)) CTXP(w_in, in(4)) CTXP(lb_logits, in(5)) CTXP(hg_norm_g, in(6))
    CTXP(rpb, in(7)) CTXP(w_out, in(8)) CTXP(ln_g, in(9)) CTXP(ln_b, in(10)) CTXP(out, a->out)
    CTXP(mod, (float*)(wsp() + WS_MOD)) CTXP(lb, (float*)(wsp() + WS_LB)) CTXP(wt_in, (bf16*)(wsp() + WS_WTIN)) CTXP(wt_out, (bf16*)(wsp() + WS_WTOUT))
    CTXP(H, (bf16*)(wsp() + WS_H)) CTXP(P, (bf16*)(wsp() + WS_P)) CTXP(Y, (bf16*)(wsp() + WS_Y)) CTXP(obuf, (float*)(wsp() + WS_OBUF))
#undef CTXP
};

__device__ __forceinline__ void phase_prologue(Ctx& F) {
    LAS float* scr = (LAS float*)(F.lds + F.wave * 16384);
    const int gw = blockIdx.x * 8 + F.wave, NGW = gridDim.x * 8;
    constexpr int I_IN = (DM / 64) * (INC / 32), I_OUT = (MIXW / 64) * (DM / 32);
    for (int it = gw; it < DEPTH * (I_IN + I_OUT); it += NGW) {
        int l = it / (I_IN + I_OUT), r = it % (I_IN + I_OUT);
        if (r < I_IN) p0_transpose_item(F.w_in() + (size_t)l * DM * INC, DM, INC, F.wt_in() + (size_t)l * INC * DM, scr, r, F.lane);
        else p0_transpose_item(F.w_out() + (size_t)l * MIXW * DM, MIXW, DM, F.wt_out() + (size_t)l * DM * MIXW, scr, r - I_IN, F.lane);
    }
    __syncthreads();
    LAS float* sc = (LAS float*)F.lds;
    LAS float* red = (LAS float*)(F.lds + 32768);
    for (int it = blockIdx.x; it < DEPTH * (ADAC / 64); it += gridDim.x) {
        const int l = it / (ADAC / 64), j0 = (it % (ADAC / 64)) * 64;
        for (int i = F.tid; i < NB * DM; i += 512) { const float v = F.c()[i]; sc[i] = v * sigmoidf_(v); }
        __syncthreads();
        const int kq = F.tid >> 6, jj = F.tid & 63;
        float acc[8];
#pragma unroll
        for (int b = 0; b < 8; ++b) acc[b] = 0.f;
        const float* w = F.ada_w() + (size_t)l * DM * ADAC + j0 + jj;
#pragma unroll 8
        for (int k = kq; k < DM; k += 8) { const float wv = w[(size_t)k * ADAC];
#pragma unroll
            for (int b = 0; b < 8; ++b) acc[b] += sc[b * DM + k] * wv; }
#pragma unroll
        for (int b = 0; b < 8; ++b) red[(kq * 8 + b) * 64 + jj] = acc[b];
        __syncthreads();
        { const int b = F.tid >> 6; float s = 0.f;
#pragma unroll
          for (int q = 0; q < 8; ++q) s += red[(q * 8 + b) * 64 + jj];
          F.mod()[((size_t)l * NB + b) * ADAC + j0 + jj] = s + F.ada_b()[l * ADAC + j0 + jj]; }
        __syncthreads();
    }
    if (blockIdx.x == 0) { unsigned* ctl = (unsigned*)(F.wsp() + WS_CTL); for (int i = F.tid; i < DEPTH * 64; i += 512) ctl[CW_HG + i * 64] = 0u; }
    if (blockIdx.x == gridDim.x - 1) {
        for (int i = F.tid; i < 2 * 1024; i += 512) { const int ds = i >> 10, ch = i & 1023;
            float lg[4], mx = -1e30f;
#pragma unroll
            for (int l = 0; l < 4; ++l) { lg[l] = F.lb_logits()[(ds * 4 + l) * 1024 + ch]; mx = fmaxf(mx, lg[l]); }
            float s = 0.f;
#pragma unroll
            for (int l = 0; l < 4; ++l) { lg[l] = __expf(lg[l] - mx); s += lg[l]; }
            const float inv = 1.f / s; float cs = 0.f;
            F.lb()[(ds * 4 + 0) * 1024 + ch] = 0.f;
#pragma unroll
            for (int l = 1; l < 4; ++l) { cs += lg[l] * inv; F.lb()[(ds * 4 + l) * 1024 + ch] = cs; }
        }
    }
}

__device__ __forceinline__ void ln_mod_row(const float* xrow, const float* modb  , bf16* orow, int lane) {
    const f32x4* xr = (const f32x4*)xrow + lane;
    f32x4 v[4]; float s = 0.f;
#pragma unroll
    for (int j = 0; j < 4; ++j) { v[j] = xr[64 * j]; s += (v[j].x + v[j].y) + (v[j].z + v[j].w); }
    const float mean = wave_sum(s) * (1.f / DM); float s2 = 0.f;
#pragma unroll
    for (int j = 0; j < 4; ++j) { v[j] = v[j] - mean; s2 += (v[j].x * v[j].x + v[j].y * v[j].y) + (v[j].z * v[j].z + v[j].w * v[j].w); }
    const float rstd = 1.f / sqrtf(wave_sum(s2) * (1.f / DM) + LN_EPS);
    unsigned long long* o8 = (unsigned long long*)orow + lane;
#pragma unroll
    for (int j = 0; j < 4; ++j) { const f32x4 sh = *((const f32x4*)modb + lane + 64 * j), sc = *((const f32x4*)(modb + DM) + lane + 64 * j);
        const float a = v[j].x * rstd * (1.f + sc.x) + sh.x, b = v[j].y * rstd * (1.f + sc.y) + sh.y, c = v[j].z * rstd * (1.f + sc.z) + sh.z, d = v[j].w * rstd * (1.f + sc.w) + sh.w;
        o8[64 * j] = (unsigned long long)pk2(a, b) | ((unsigned long long)pk2(c, d) << 32); }
}
__device__ __forceinline__ void phase_ln0(Ctx& F) {
    const int gw = blockIdx.x * 8 + F.wave, NGW = gridDim.x * 8;
    for (int m = gw; m < MTOK; m += NGW) ln_mod_row(F.x() + (size_t)m * DM, F.mod() + (size_t)(0 * NB + (m >> 11)) * ADAC, F.H() + (size_t)m * DM, F.lane);
}
__device__ __forceinline__ void phase_ln(Ctx& F, int l) {
    const int gw = blockIdx.x * 8 + F.wave, NGW = gridDim.x * 8;
    for (int m = gw; m < MTOK; m += NGW) {
        f32x4* xr = (f32x4*)(F.out() + (size_t)m * DM) + F.lane;
        f32x4 v[4]; float s = 0.f;
#pragma unroll
        for (int j = 0; j < 4; ++j) { v[j] = xr[64 * j]; s += (v[j].x + v[j].y) + (v[j].z + v[j].w); }
        const float mean = wave_sum(s) * (1.f / DM); float s2 = 0.f;
#pragma unroll
        for (int j = 0; j < 4; ++j) { v[j] = v[j] - mean; s2 += (v[j].x * v[j].x + v[j].y * v[j].y) + (v[j].z * v[j].z + v[j].w * v[j].w); }
        const float rstd = 1.f / sqrtf(wave_sum(s2) * (1.f / DM) + LN_EPS);
        float t = 0.f;
#pragma unroll
        for (int j = 0; j < 4; ++j) { const f32x4 g = *((const f32x4*)(F.ln_g() + l * DM) + F.lane + 64 * j), b = *((const f32x4*)(F.ln_b() + l * DM) + F.lane + 64 * j);
            v[j].x = v[j].x * rstd * g.x + b.x; v[j].y = v[j].y * rstd * g.y + b.y; v[j].z = v[j].z * rstd * g.z + b.z; v[j].w = v[j].w * rstd * g.w + b.w;
            xr[64 * j] = v[j]; t += (v[j].x + v[j].y) + (v[j].z + v[j].w); }
        if (l + 1 < DEPTH) {
            const float mean2 = wave_sum(t) * (1.f / DM); float t2 = 0.f;
#pragma unroll
            for (int j = 0; j < 4; ++j) { v[j] = v[j] - mean2; t2 += (v[j].x * v[j].x + v[j].y * v[j].y) + (v[j].z * v[j].z + v[j].w * v[j].w); }
            const float rstd2 = 1.f / sqrtf(wave_sum(t2) * (1.f / DM) + LN_EPS);
            const float* modb = F.mod() + (size_t)((l + 1) * NB + (m >> 11)) * ADAC;
            unsigned long long* o8 = (unsigned long long*)(F.H() + (size_t)m * DM) + F.lane;
#pragma unroll
            for (int j = 0; j < 4; ++j) { const f32x4 sh = *((const f32x4*)modb + F.lane + 64 * j), sc = *((const f32x4*)(modb + DM) + F.lane + 64 * j);
                const float a = v[j].x * rstd2 * (1.f + sc.x) + sh.x, b = v[j].y * rstd2 * (1.f + sc.y) + sh.y, c = v[j].z * rstd2 * (1.f + sc.z) + sh.z, d = v[j].w * rstd2 * (1.f + sc.w) + sh.w;
                o8[64 * j] = (unsigned long long)pk2(a, b) | ((unsigned long long)pk2(c, d) << 32); }
        }
    }
}

__device__ __forceinline__ void hgrn_naive_unit(Ctx& F, int l, int bh) {
    const int b = bh >> 3, h = bh & 7, tid = F.tid;
    const bf16* Pb = F.P() + (size_t)b * SEQ * INC;
    LAS float* sq = (LAS float*)F.lds;
    LAS float* sf = sq + 16 * 128;
    LAS float* sk = sf + 16 * 128;
    LAS float* so = sk + 16 * 128;
    LAS float* srs = so + 16 * 128;
    const bool act = tid < 128;
    const int ch = h * 128 + (tid & 127);
    const float ng = F.hg_norm_g()[l * 128 + (tid & 127)];
    for (int pass = 1; pass >= 0; --pass) {
        float S[128];
#pragma unroll
        for (int d = 0; d < 128; ++d) S[d] = 0.f;
        const float lbv = F.lb()[(pass * 4 + l) * 1024 + ch];
        const int zc = pass ? C_ZBW : C_ZFW;
        for (int c = 0; c < SEQ / 16; ++c) {
            if (act) {
#pragma unroll 4
                for (int i = 0; i < 16; ++i) { const int tt = c * 16 + i, tok = pass ? (SEQ - 1 - tt) : tt; const bf16* row = Pb + (size_t)tok * INC;
                    const float q = bf2f(row[C_QH + ch]), z = bf2f(row[zc + ch]);
                    const float f = lbv + (1.f - lbv) * sigmoidf_(z);
                    sq[i * 128 + tid] = q; sf[i * 128 + tid] = f; sk[i * 128 + tid] = 1.f - f; }
            }
            __syncthreads();
            if (act) {
                for (int i = 0; i < 16; ++i) { const int tt = c * 16 + i, tok = pass ? (SEQ - 1 - tt) : tt; const bf16* row = Pb + (size_t)tok * INC;
                    const float vt = bf2f(row[C_IH + ch]); float o = 0.f;
#pragma unroll
                    for (int d = 0; d < 128; ++d) { S[d] = sf[i * 128 + d] * S[d] + sk[i * 128 + d] * vt; o += sq[i * 128 + d] * S[d]; }
                    float* op = F.obuf() + ((size_t)b * SEQ + tok) * 1024 + ch;
                    if (pass) *op = o; else so[i * 128 + tid] = o + *op; }
            }
            __syncthreads();
            if (pass == 0) {
                if (tid < 16) { float ss = 0.f; for (int d = 0; d < 128; ++d) { const float v = so[tid * 128 + d]; ss += v * v; } srs[tid] = 1.f / sqrtf(ss * (1.f / 128.f) + RMS_EPS); }
                __syncthreads();
                if (act) { for (int i = 0; i < 16; ++i) { const int tok = c * 16 + i; const bf16* row = Pb + (size_t)tok * INC;
                        const float g = bf2f(row[C_GH + ch]); const float y = so[i * 128 + tid] * srs[i] * ng * (g * sigmoidf_(g));
                        F.Y()[((size_t)b * SEQ + tok) * MIXW + ch] = (bf16)f2bf(y); } }
                __syncthreads();
            }
        }
    }
}
__device__ __forceinline__ void na_naive_items(Ctx& F, int l) {
    LAS float* sp = (LAS float*)(F.lds + 65536) + F.wave * 128;
    const int lane = F.lane;
    for (int it0 = blockIdx.x * 8; it0 < MTOK * 16; it0 += gridDim.x * 8) {
        const int it = it0 + F.wave;
        const int tokq = it >> 4, h = it & 15, b = tokq >> 11, r = (tokq >> 6) & 31, col = tokq & 63;
        const int rs = min(max(r - 4, 0), 24), cs = min(max(col - 8, 0), 48);
        const bf16* qrow = F.P() + (size_t)tokq * INC + C_QN + h * 64;
        float s2[2];
#pragma unroll
        for (int e = 0; e < 2; ++e) { const int kk = lane + 64 * e, kr = kk >> 4, kc = kk & 15; const int tokk = b * SEQ + (rs + kr) * 64 + cs + kc;
            const bf16* krow = F.P() + (size_t)tokk * INC + C_KN + h * 64; float dot = 0.f;
#pragma unroll
            for (int d8 = 0; d8 < 8; ++d8) { const v4u qa = *(const v4u*)(qrow + d8 * 8), ka = *(const v4u*)(krow + d8 * 8);
#pragma unroll
                for (int w = 0; w < 4; ++w) { dot += __uint_as_float(qa[w] << 16) * __uint_as_float(ka[w] << 16) + __uint_as_float(qa[w] & 0xffff0000u) * __uint_as_float(ka[w] & 0xffff0000u); } }
            const float bias = F.rpb()[(((size_t)l * 16 + h) * 15 + (rs + kr - r + 7)) * 31 + (cs + kc - col + 15)];
            s2[e] = dot * 0.125f + bias; }
        const float mx = wave_max(fmaxf(s2[0], s2[1]));
        const float p0 = __expf(s2[0] - mx), p1 = __expf(s2[1] - mx);
        const float sum = wave_sum(p0 + p1);
        sp[lane] = p0; sp[lane + 64] = p1;
        asm volatile("s_waitcnt lgkmcnt(0)" ::: "memory");
        float o = 0.f;
        for (int kk = 0; kk < 128; ++kk) { const int kr = kk >> 4, kc = kk & 15; const int tokk = b * SEQ + (rs + kr) * 64 + cs + kc;
            o += sp[kk] * bf2f(F.P()[(size_t)tokk * INC + C_VN + h * 64 + lane]); }
        const float g = bf2f(F.P()[(size_t)tokq * INC + C_GN + h * 64 + lane]);
        F.Y()[(size_t)tokq * MIXW + 1024 + h * 64 + lane] = (bf16)f2bf(o / sum * (g * sigmoidf_(g)));
        asm volatile("s_waitcnt lgkmcnt(0)" ::: "memory");
    }
}
__device__ __forceinline__ void phase_mix_naive(Ctx& F, int l) {
    for (int u = blockIdx.x; u < 64; u += gridDim.x) hgrn_naive_unit(F, l, u);
    __syncthreads();
    na_naive_items(F, l);
}


typedef float hf32x4 __attribute__((ext_vector_type(4)));
constexpr int HG_RS = 272, HG_TS = 80;
constexpr int HG_QM = 0, HG_KM = 8704, HG_KMT = 17408, HG_VT = 27648, HG_C = 37888, HG_A = 38912, HG_CHUNK = 41472;
__device__ __forceinline__ float* hg_obw(Ctx& F, int b) { return b < 4 ? (float*)(F.wsp() + WS_H) + (size_t)b * SEQ * 1024 : (float*)(F.wsp() + WS_OB2) + (size_t)(b - 4) * SEQ * 1024; }
__device__ __forceinline__ bf16x8 ld_frag(LAS unsigned char* p) { return *(LAS bf16x8*)p; }
#define MFMA16(a, b, c) __builtin_amdgcn_mfma_f32_16x16x32_bf16((a), (b), (c), 0, 0, 0)

__device__ __forceinline__ void hgrn_unit(Ctx& F, int l, int unit) {
    const int dir = unit & 1, bh = unit >> 1, b = bh >> 3, h = bh & 7;
    const int lane = F.lane, wv = F.wave;
    LAS unsigned char* L = F.lds;
    const bf16* Pb = F.P() + (size_t)b * SEQ * INC;
    float* Ob = dir ? hg_obw(F, b) : F.obuf() + (size_t)b * SEQ * 1024;
    const int par = wv >> 2, cpg = (wv >> 1) & 1, qp = wv & 1;
    const int cp = 32 * cpg + (lane & 31), quarter = 2 * qp + (lane >> 5), t0 = 8 * quarter;
    const int ci = cp & 15, grp = cp >> 4;
    const int pi = (((ci >> 1) & 3) << 2) | (((ci >> 3) & 1) << 1) | (ci & 1);
    const int chA = h * 128 + 2 * cp;
    const float lb0 = F.lb()[(dir * 4 + l) * 1024 + chA], lb1 = F.lb()[(dir * 4 + l) * 1024 + chA + 1];
    const int zc = dir ? C_ZBW : C_ZFW;
    LAS unsigned char* Lp = L + par * HG_CHUNK;
    const int fr = lane & 15, g = lane >> 4;
    unsigned rq[8], rz[8], rv[8];
#define HG_LOAD_RAW(R) do { _Pragma("unroll") for (int i = 0; i < 8; ++i) { const int p_ = 32 * (2 * (R) + par) + t0 + i; const int tok_ = dir ? (SEQ - 1 - p_) : p_; \
        const bf16* row_ = Pb + (size_t)tok_ * INC + chA; rq[i] = *(const unsigned*)(row_ + C_QH); rz[i] = *(const unsigned*)(row_ + zc); rv[i] = *(const unsigned*)(row_ + C_IH); } } while (0)
    HG_LOAD_RAW(0);
    hf32x4 T[8];
#pragma unroll
    for (int mt = 0; mt < 8; ++mt) T[mt] = (hf32x4){0.f, 0.f, 0.f, 0.f};
    for (int R = 0; R < SEQ / 64; ++R) {
        {
            float qm[2][8], km[2][8]; float tot[2];
#pragma unroll
            for (int e = 0; e < 2; ++e) {
                const float lbe = e ? lb1 : lb0;
                float q[8], f[8], k[8];
#pragma unroll
                for (int i = 0; i < 8; ++i) { q[i] = e ? __uint_as_float(rq[i] & 0xffff0000u) : __uint_as_float(rq[i] << 16);
                    const float z = e ? __uint_as_float(rz[i] & 0xffff0000u) : __uint_as_float(rz[i] << 16);
                    const float sg = sigmoidf_(z); f[i] = lbe + (1.f - lbe) * sg; k[i] = 1.f - f[i]; }
                if (qp == 0) {
                    float Rl[8]; Rl[7] = 1.f;
#pragma unroll
                    for (int i = 6; i >= 0; --i) Rl[i] = Rl[i + 1] * f[i + 1];
                    const float tt = Rl[0] * f[0]; const float oth = __shfl_xor(tt, 32); const float mult = (lane < 32) ? oth : 1.f;
#pragma unroll
                    for (int i = 0; i < 8; ++i) { const float Rv = Rl[i] * mult; qm[e][i] = q[i] * __builtin_amdgcn_rcpf(Rv); km[e][i] = k[i] * Rv; }
                    tot[e] = tt * oth;
                } else {
                    float El[8]; El[0] = f[0];
#pragma unroll
                    for (int i = 1; i < 8; ++i) El[i] = El[i - 1] * f[i];
                    const float tt = El[7]; const float oth = __shfl_xor(tt, 32); const float mult = (lane >= 32) ? oth : 1.f;
#pragma unroll
                    for (int i = 0; i < 8; ++i) { const float Ev = El[i] * mult; qm[e][i] = q[i] * Ev; km[e][i] = k[i] * __builtin_amdgcn_rcpf(Ev); }
                    tot[e] = tt * oth;
                }
            }
#pragma unroll
            for (int i = 0; i < 8; ++i) {
                *(LAS unsigned*)(Lp + HG_QM + (t0 + i) * HG_RS + (grp * 16 + pi) * 4) = pk2(qm[0][i], qm[1][i]);
                *(LAS unsigned*)(Lp + HG_KM + (t0 + i) * HG_RS + (grp * 16 + pi) * 4) = pk2(km[0][i], km[1][i]);
            }
#pragma unroll
            for (int e = 0; e < 2; ++e) {
                v4u kk, vv;
                kk.x = pk2(km[e][0], km[e][1]); kk.y = pk2(km[e][2], km[e][3]); kk.z = pk2(km[e][4], km[e][5]); kk.w = pk2(km[e][6], km[e][7]);
                if (e == 0) { vv.x = (rv[0] & 0xffffu) | (rv[1] << 16); vv.y = (rv[2] & 0xffffu) | (rv[3] << 16); vv.z = (rv[4] & 0xffffu) | (rv[5] << 16); vv.w = (rv[6] & 0xffffu) | (rv[7] << 16); }
                else        { vv.x = (rv[0] >> 16) | (rv[1] & 0xffff0000u); vv.y = (rv[2] >> 16) | (rv[3] & 0xffff0000u); vv.z = (rv[4] >> 16) | (rv[5] & 0xffff0000u); vv.w = (rv[6] >> 16) | (rv[7] & 0xffff0000u); }
                *(LAS v4u*)(Lp + HG_KMT + (2 * cp + e) * HG_TS + quarter * 16) = kk;
                *(LAS v4u*)(Lp + HG_VT + (2 * cp + e) * HG_TS + quarter * 16) = vv;
            }
            if (quarter == 0) { *(LAS float*)(Lp + HG_C + (2 * cp) * 4) = tot[0]; *(LAS float*)(Lp + HG_C + (2 * cp + 1) * 4) = tot[1]; }
            if (quarter == 3) { *(LAS float*)(Lp + HG_C + 512 + (2 * cp) * 4) = tot[0]; *(LAS float*)(Lp + HG_C + 512 + (2 * cp + 1) * 4) = tot[1]; }
        }
        if (R + 1 < SEQ / 64) HG_LOAD_RAW(R + 1);
        __syncthreads();
        {
            LAS unsigned char* La = L + (wv >> 2) * HG_CHUNK; const int tile = wv & 3, ti = tile >> 1, si = tile & 1;
            v2u w2;
            if (tile == 1) { w2.x = 0u; w2.y = 0u; }
            else {
                hf32x4 acc = (hf32x4){0.f, 0.f, 0.f, 0.f};
#pragma unroll
                for (int u = 0; u < 4; ++u) { const bf16x8 a = ld_frag(La + HG_KM + (16 * si + fr) * HG_RS + u * 64 + g * 16), bq = ld_frag(La + HG_QM + (16 * ti + fr) * HG_RS + u * 64 + g * 16);
                    acc = MFMA16(a, bq, acc); }
                const int tt = 16 * ti + fr, s0 = 16 * si + 4 * g;
                const float a0 = (s0 + 0 <= tt) ? acc[0] : 0.f, a1 = (s0 + 1 <= tt) ? acc[1] : 0.f, a2 = (s0 + 2 <= tt) ? acc[2] : 0.f, a3 = (s0 + 3 <= tt) ? acc[3] : 0.f;
                w2.x = pk2(a0, a1); w2.y = pk2(a2, a3);
            }
            *(LAS v2u*)(La + HG_A + (16 * ti + fr) * HG_TS + (16 * si + 4 * g) * 2) = w2;
        }
        __syncthreads();
#pragma unroll
        for (int cpar = 0; cpar < 2; ++cpar) {
            LAS unsigned char* Lc = L + cpar * HG_CHUNK; const int n = 2 * R + cpar;
#pragma unroll
            for (int mt = 0; mt < 8; ++mt) { const hf32x4 cv = *(LAS hf32x4*)(Lc + HG_C + (16 * mt + 4 * g) * 4); T[mt] = T[mt] * cv; }
            bf16x8 Tb[4];
#pragma unroll
            for (int u = 0; u < 4; ++u) { v4u t4; t4.x = pk2(T[2 * u][0], T[2 * u][1]); t4.y = pk2(T[2 * u][2], T[2 * u][3]); t4.z = pk2(T[2 * u + 1][0], T[2 * u + 1][1]); t4.w = pk2(T[2 * u + 1][2], T[2 * u + 1][3]);
                Tb[u] = __builtin_bit_cast(bf16x8, t4); }
            const bf16x8 vfrag = ld_frag(Lc + HG_VT + (16 * wv + fr) * HG_TS + g * 16);
            hf32x4 o[2];
#pragma unroll
            for (int ti = 0; ti < 2; ++ti) { o[ti] = (hf32x4){0.f, 0.f, 0.f, 0.f};
#pragma unroll
                for (int u = 0; u < 4; ++u) { const bf16x8 a = ld_frag(Lc + HG_QM + (16 * ti + fr) * HG_RS + u * 64 + g * 16); o[ti] = MFMA16(a, Tb[u], o[ti]); }
                const bf16x8 aa = ld_frag(Lc + HG_A + (16 * ti + fr) * HG_TS + g * 16); o[ti] = MFMA16(aa, vfrag, o[ti]); }
#pragma unroll
            for (int ti = 0; ti < 2; ++ti)
#pragma unroll
                for (int r = 0; r < 4; ++r) { const int p_ = 32 * n + 16 * ti + 4 * g + r; const int tok_ = dir ? (SEQ - 1 - p_) : p_; Ob[(size_t)tok_ * 1024 + h * 128 + 16 * wv + fr] = o[ti][r]; }
#pragma unroll
            for (int mt = 0; mt < 8; ++mt) { const bf16x8 a = ld_frag(Lc + HG_KMT + (16 * mt + fr) * HG_TS + g * 16); T[mt] = MFMA16(a, vfrag, T[mt]); }
#pragma unroll
            for (int mt = 0; mt < 8; ++mt) { const hf32x4 cv = *(LAS hf32x4*)(Lc + HG_C + 512 + (16 * mt + 4 * g) * 4); T[mt] = T[mt] * cv; }
        }
        __syncthreads();
    }
#undef HG_LOAD_RAW
}
__device__ __forceinline__ void hgrn_finalize(Ctx& F, int l, int bh) {
    const int b = bh >> 3, h = bh & 7, lane = F.lane, tq = lane >> 4, cl = lane & 15;
    const float* Of = F.obuf() + (size_t)b * SEQ * 1024; const float* Obw = hg_obw(F, b);
    const f32x4 ng0 = *(const f32x4*)(F.hg_norm_g() + l * 128 + 8 * cl), ng1 = *(const f32x4*)(F.hg_norm_g() + l * 128 + 8 * cl + 4);
    for (int t4 = F.wave; t4 < SEQ / 4; t4 += 8) {
        const int tok = 4 * t4 + tq; const size_t off = (size_t)tok * 1024 + h * 128 + 8 * cl;
        f32x4 a0 = *(const f32x4*)(Of + off), a1 = *(const f32x4*)(Of + off + 4); const f32x4 b0 = *(const f32x4*)(Obw + off), b1 = *(const f32x4*)(Obw + off + 4);
        a0 = a0 + b0; a1 = a1 + b1;
        float ss = (a0.x * a0.x + a0.y * a0.y) + (a0.z * a0.z + a0.w * a0.w) + (a1.x * a1.x + a1.y * a1.y) + (a1.z * a1.z + a1.w * a1.w);
        ss += __shfl_xor(ss, 1); ss += __shfl_xor(ss, 2); ss += __shfl_xor(ss, 4); ss += __shfl_xor(ss, 8);
        const float rs = 1.f / sqrtf(ss * (1.f / 128.f) + RMS_EPS);
        const v4u gq = *(const v4u*)(F.P() + ((size_t)b * SEQ + tok) * INC + C_GH + h * 128 + 8 * cl);
        float gv[8];
#pragma unroll
        for (int w = 0; w < 4; ++w) { gv[2 * w] = __uint_as_float(gq[w] << 16); gv[2 * w + 1] = __uint_as_float(gq[w] & 0xffff0000u); }
        float y[8];
        y[0] = a0.x * rs * ng0.x; y[1] = a0.y * rs * ng0.y; y[2] = a0.z * rs * ng0.z; y[3] = a0.w * rs * ng0.w;
        y[4] = a1.x * rs * ng1.x; y[5] = a1.y * rs * ng1.y; y[6] = a1.z * rs * ng1.z; y[7] = a1.w * rs * ng1.w;
#pragma unroll
        for (int w = 0; w < 8; ++w) y[w] *= gv[w] * sigmoidf_(gv[w]);
        v4u o; o.x = pk2(y[0], y[1]); o.y = pk2(y[2], y[3]); o.z = pk2(y[4], y[5]); o.w = pk2(y[6], y[7]);
        *(v4u*)(F.Y() + ((size_t)b * SEQ + tok) * MIXW + h * 128 + 8 * cl) = o;
    }
}
__device__ __forceinline__ void phase_mix(Ctx& F, int l) {
    unsigned* ctl = (unsigned*)(F.wsp() + WS_CTL);
    volatile LAS unsigned* flag = (volatile LAS unsigned*)(F.lds + LDS_FLAG);
    for (int u = blockIdx.x; u < 128; u += gridDim.x) {
        hgrn_unit(F, l, u);
        asm volatile("s_waitcnt vmcnt(0)" ::: "memory");
        __syncthreads();
        if (F.tid == 0) {
            __builtin_amdgcn_fence(__ATOMIC_RELEASE, "agent");
            asm volatile("s_waitcnt vmcnt(0)" ::: "memory");
            const unsigned old = __hip_atomic_fetch_add(ctl + CW_HG + (l * 64 + (u >> 1)) * 64, 1u, __ATOMIC_RELAXED, __HIP_MEMORY_SCOPE_AGENT);
            if (old == 1u) { __builtin_amdgcn_fence(__ATOMIC_ACQUIRE, "agent"); asm volatile("s_waitcnt vmcnt(0)" ::: "memory"); }
            flag[0] = old;
        }
        __syncthreads();
        const bool last = flag[0] == 1u;
        __syncthreads();
        if (last) hgrn_finalize(F, l, u >> 1);
    }
    __syncthreads();
    na_naive_items(F, l);
}

__global__ void __launch_bounds__(512, 2) fwd_kernel(Args a) {
    extern __shared__ __attribute__((aligned(16))) unsigned char lds[];
    Ctx F;
    F.lds = (LAS unsigned char*)lds; F.tid = threadIdx.x; F.lane = F.tid & 63; F.wave = __builtin_amdgcn_readfirstlane(F.tid >> 6);
    F.a = &a;
    for (int ph = a.ph_lo; ph < a.ph_hi; ++ph) {
        { int t_ = threadIdx.x; asm volatile("" : "+v"(t_)); F.tid = t_; F.lane = t_ & 63; F.wave = __builtin_amdgcn_readfirstlane(t_ >> 6); }
        if (ph == 0) phase_prologue(F);
        else if (ph == 1) phase_ln0(F);
        else {
            const int l = (ph - 2) >> 2, k = (ph - 2) & 3;
            if (k == 0) {
                pg8::Gemm g{F.H(), F.wt_in() + (size_t)l * INC * DM, MTOK, INC, DM}; pg8::StaticOrder S; S.init(MTOK, INC, gridDim.x, (int)blockIdx.x);
                pg8::EpiBf16<0> E{F.P(), INC, nullptr, 0, 0, 1.f};
                pg8::gemm_phase<pg8::EpiBf16<0>, pg8::StaticOrder, true, true>(F.lds, g, S, E);
            } else if (k == 1) {
                phase_mix(F, l);
            } else if (k == 2) {
                pg8::Gemm g{F.Y(), F.wt_out() + (size_t)l * DM * MIXW, MTOK, DM, MIXW}; pg8::StaticOrder S; S.init(MTOK, DM, gridDim.x, (int)blockIdx.x);
                EpiZ E{l == 0 ? F.x() : F.out(), F.out(), F.mod() + (size_t)l * NB * ADAC + 2 * DM};
                pg8::gemm_phase<EpiZ, pg8::StaticOrder, false, true>(F.lds, g, S, E);
            } else {
                phase_ln(F, l);
            }
        }
        if (ph + 1 < a.ph_hi) { __syncthreads(); cg::this_grid().sync(); }
    }
}

__global__ void fill_kernel(float* o, int n, float v) { for (int i = blockIdx.x * blockDim.x + threadIdx.x; i < n; i += gridDim.x * blockDim.x) o[i] = v; }

extern "C" void kernel_launch(void* const* d_in, const int* in_sizes, int n_in, void* d_out, int out_size, void* d_ws, size_t ws_size, hipStream_t stream) {
    static int grid = 0;
    if (grid == 0) {
        int dev = 0, cus = 0;
        if (hipGetDevice(&dev) != hipSuccess || hipDeviceGetAttribute(&cus, hipDeviceAttributeMultiprocessorCount, dev) != hipSuccess) { grid = -1; return; }
        if (hipFuncSetAttribute((const void*)fwd_kernel, hipFuncAttributeMaxDynamicSharedMemorySize, LDS_BYTES) != hipSuccess) { grid = -1; return; }
        int per_cu = 0;
        if (hipOccupancyMaxActiveBlocksPerMultiprocessor(&per_cu, (const void*)fwd_kernel, 512, LDS_BYTES) != hipSuccess || per_cu < 1) { fprintf(stderr, "occupancy query: %d\n", per_cu); }
        (void)hipGetLastError();
        grid = cus * (per_cu < 1 ? 1 : (per_cu > 1 ? 1 : per_cu));
    }
    if (grid < 0) return;
    if (n_in != 11 || out_size != MTOK * DM || ws_size < WS_END) { fill_kernel<<<256, 256, 0, stream>>>((float*)d_out, out_size, ws_size < WS_END ? 12345.0f : 54321.0f); return; }
    Args a{};
    for (int i = 0; i < 11; ++i) a.in[i] = (const float*)d_in[i];
    a.out = (float*)d_out; a.ws = (unsigned char*)d_ws;
    a.ph_lo = 0; a.ph_hi = NPHASE; a.coop = 1;
    void* kargs[] = {&a};
    hipError_t e = hipLaunchCooperativeKernel((const void*)fwd_kernel, dim3(grid), dim3(512), kargs, LDS_BYTES, stream);
    if (e != hipSuccess) fprintf(stderr, "cooperative launch failed: %s (grid %d)\n", hipGetErrorString(e), grid);
}
```

```cpp
#include <hip/hip_runtime.h>
#include <hip/hip_cooperative_groups.h>
#include <cstdio>
#include <cstdint>
namespace pg8 {
#define PG8_LAS __attribute__((address_space(3)))
typedef unsigned short bf16_t;
typedef short bf16x8 __attribute__((ext_vector_type(8)));
typedef float f32x4 __attribute__((ext_vector_type(4)));
typedef unsigned u32x4 __attribute__((ext_vector_type(4)));
constexpr int BM = 256, BK = 64, HALF = 128, HTB = HALF * BK * 2  , STAGE_BYTES = 8 * HTB, NXCD = 8, WGM = 8;

__host__ __device__ __forceinline__ int lds_byte(int r, int c) { const int st = (r >> 4) * 2 + (c >> 5), rr = r & 15, cc = c & 31, ob = rr * 64 + cc * 2; return st * 1024 + (ob ^ (((ob >> 9) & 1) << 5)); }
__host__ __device__ __forceinline__ void stage_rc(int b, int& R, int& C) { const int st = b / 1024, sb = b % 1024, swz = sb ^ (((sb >> 9) & 1) << 5); R = (st >> 1) * 16 + swz / 64; C = (st & 1) * 32 + (swz % 64) / 2; }
__host__ __device__ __forceinline__ int perm32(int rho) { const int n = rho >> 4, i = rho & 15; return 8 * (i >> 2) + 4 * n + (i & 3); }

struct Unit { int pm, pn; };
struct Gemm { const bf16_t* A; const bf16_t* Bt; int M, N, K; };

struct StaticOrder {
    int nM, nN, nwg, G, c;
    __host__ __device__ void init(int M, int N, int G_, int c_) { nM = M / BM; nN = N / BM; nwg = nM * nN; G = G_; c = c_; }
    __host__ __device__ bool next(int i, Unit& u) const {
        const long L = (long)i * G + c; if (L >= nwg) return false;
        int wgid = (int)L; { const int q = nwg / NXCD, r = nwg % NXCD, xcd = wgid % NXCD, off = wgid / NXCD; wgid = (xcd < r ? xcd * (q + 1) : r * (q + 1) + (xcd - r) * q) + off; }
        const int nig = WGM * nN, gid = wgid / nig, fm = gid * WGM, gsz = (nM - fm) < WGM ? (nM - fm) : WGM;
        u.pm = fm + ((wgid % nig) % gsz); u.pn = (wgid % nig) / gsz; return true;
    }
    __device__ __forceinline__ void a_ready(const Unit&) const {}
    __device__ __forceinline__ void done(const Unit&) const {}
};

__device__ __forceinline__ unsigned cvt_pk_bf16(float lo, float hi) { unsigned r; asm volatile("v_cvt_pk_bf16_f32 %0, %1, %2" : "=v"(r) : "v"(lo), "v"(hi)); return r; }
typedef float f32x2 __attribute__((ext_vector_type(2)));
__device__ __forceinline__ f32x2 gelu_pk(f32x2 v) {
    const f32x2 av = __builtin_elementwise_abs(v), d = av * 0.2316418882f + 1.0f;
    f32x2 t; t.x = __builtin_amdgcn_rcpf(d.x); t.y = __builtin_amdgcn_rcpf(d.y);
    f32x2 q = t * 0.5307027145f + (-0.7265760135f); q = q * t + 0.7107068705f; q = q * t + (-0.142248368f); q = q * t + 0.127414796f; q = q * t;
    const f32x2 s = (v * v) * (-0.72134752044f);
    f32x2 e; e.x = __builtin_amdgcn_exp2f(s.x); e.y = __builtin_amdgcn_exp2f(s.y);
    const f32x2 m = v * (q * e), r = v - m;
    f32x2 o; o.x = v.x < 0.f ? m.x : r.x; o.y = v.y < 0.f ? m.y : r.y; return o;
}

template <int ACT  > struct EpiBf16 {
    static constexpr bool PERM = true, AFTER_DRAIN = false; static_assert(ACT == 0 || ACT == 1, "EpiBf16: ACT is 0 (none) or 1 (gelu_pk)");
    bf16_t* O; int ldc; const float* bias; int split_cols; size_t split_stride; float scale0;
    __device__ __forceinline__ void operator()(const f32x4 (&acc)[2][2][4][2], const Unit& u, int wr, int wc, int fr, int fq) const {
        const int row0 = u.pm * BM + wr * 64 + fr; int colt = u.pn * BM; bf16_t* base = O;
        float sc = 1.f; if (split_cols) { const int t = colt / split_cols; base += (size_t)t * split_stride; colt -= t * split_cols; if (t == 0) sc = scale0; }
        const int col0 = colt + wc * 32 + 8 * fq, bcol0 = u.pn * BM + wc * 32 + 8 * fq;
        f32x4 bv[2][2];
#pragma unroll
        for (int bj = 0; bj < 2; ++bj)
#pragma unroll
            for (int n = 0; n < 2; ++n) bv[bj][n] = bias ? *(const f32x4*)(bias + bcol0 + bj * HALF + 4 * n) : (f32x4){0.f, 0.f, 0.f, 0.f};
#pragma unroll
        for (int ai = 0; ai < 2; ++ai)
#pragma unroll
            for (int m = 0; m < 4; ++m) { bf16_t* rowp = base + (size_t)(row0 + ai * HALF + m * 16) * ldc + col0;
#pragma unroll
                for (int bj = 0; bj < 2; ++bj) { f32x4 v0 = acc[ai][bj][m][0] + bv[bj][0], v1 = acc[ai][bj][m][1] + bv[bj][1];
                    if (ACT == 1) { f32x2 a = gelu_pk((f32x2){v0[0], v0[1]}), b = gelu_pk((f32x2){v0[2], v0[3]}), c = gelu_pk((f32x2){v1[0], v1[1]}), d = gelu_pk((f32x2){v1[2], v1[3]});
                        v0 = (f32x4){a.x, a.y, b.x, b.y}; v1 = (f32x4){c.x, c.y, d.x, d.y}; }
                    v0 = v0 * sc; v1 = v1 * sc; u32x4 w; w.x = cvt_pk_bf16(v0[0], v0[1]); w.y = cvt_pk_bf16(v0[2], v0[3]); w.z = cvt_pk_bf16(v1[0], v1[1]); w.w = cvt_pk_bf16(v1[2], v1[3]);
                    *(u32x4*)(rowp + bj * HALF) = w; } }
    }
};

struct PanelStats {
    unsigned* xbuf;
    unsigned* cnt;
    unsigned* tmo;
    int ntn; float eps;
    unsigned code;
    __device__ __forceinline__ bool run(const f32x4 (&v)[2][2][4][2], const Unit& u, int wr, int wc, int fr, int fq, PG8_LAS unsigned char* lds, int wid, int lane) const {
        typedef float f32x2v __attribute__((ext_vector_type(2)));
        PG8_LAS f32x2v* P = (PG8_LAS f32x2v*)lds;
        PG8_LAS f32x2v* S = (PG8_LAS f32x2v*)(lds + 8192);
        PG8_LAS unsigned* flag = (PG8_LAS unsigned*)(lds + 8192 + 2048);
#pragma unroll
        for (int ai = 0; ai < 2; ++ai)
#pragma unroll
            for (int m = 0; m < 4; ++m) {
                float s = 0.f;
#pragma unroll
                for (int bj = 0; bj < 2; ++bj)
#pragma unroll
                    for (int n = 0; n < 2; ++n) { const f32x4 x = v[ai][bj][m][n]; s += (x[0] + x[1]) + (x[2] + x[3]); }
                s += __shfl_xor(s, 16); s += __shfl_xor(s, 32);
                const float mw = s * (1.0f / 64.0f); float q = 0.f;
#pragma unroll
                for (int bj = 0; bj < 2; ++bj)
#pragma unroll
                    for (int n = 0; n < 2; ++n) { const f32x4 d = v[ai][bj][m][n] - mw; q += (d[0] * d[0] + d[1] * d[1]) + (d[2] * d[2] + d[3] * d[3]); }
                q += __shfl_xor(q, 16); q += __shfl_xor(q, 32);
                if (fq == 0) P[(ai * HALF + wr * 64 + m * 16 + fr) * 4 + wc] = (f32x2v){mw, q};
            }
        asm volatile("s_waitcnt lgkmcnt(0)" ::: "memory"); __builtin_amdgcn_s_barrier(); asm volatile("" ::: "memory");
#if defined(BROKEN_EXCHANGE_NO_WAIT)
#warning BROKEN CONTROL BUILD: the row-statistics exchange does not wait; results are wrong by design
        if (blockIdx.x >= 64) { const long long t0_ = clock64(); while (clock64() - t0_ < 60000) __builtin_amdgcn_s_sleep(8); }
#endif
        const int row = wid * 32 + (lane & 31);
        if (lane < 32) {
            const f32x2v a = P[row * 4 + 0], b = P[row * 4 + 1], c = P[row * 4 + 2], d = P[row * 4 + 3];
            const float mt = (a.x + b.x + c.x + d.x) * 0.25f;
            const float da = a.x - mt, db = b.x - mt, dc = c.x - mt, dd = d.x - mt;
            const float m2 = (a.y + b.y) + (c.y + d.y) + 64.0f * ((da * da + db * db) + (dc * dc + dd * dd));
            unsigned long long* slot = (unsigned long long*)xbuf + ((size_t)(u.pm * BM + row) * 4 + u.pn);
            __hip_atomic_store(slot, ((unsigned long long)__float_as_uint(m2) << 32) | __float_as_uint(mt), __ATOMIC_RELAXED, __HIP_MEMORY_SCOPE_AGENT);
        }
        asm volatile("s_waitcnt vmcnt(0)" ::: "memory");
        if (lane == 0) __hip_atomic_fetch_add(cnt + 64 * u.pm, 1u, __ATOMIC_RELAXED, __HIP_MEMORY_SCOPE_AGENT);
        if (wid == 0) {
            bool dead = false; const unsigned long long t0 = __builtin_amdgcn_s_memrealtime(); const unsigned want = 8u * (unsigned)ntn;
            for (;;) {
#if defined(BROKEN_EXCHANGE_NO_WAIT)
                break;
#endif
                if ((unsigned)__builtin_amdgcn_readfirstlane(__hip_atomic_load(cnt + 64 * u.pm, __ATOMIC_RELAXED, __HIP_MEMORY_SCOPE_AGENT)) >= want) break;
                if (__builtin_amdgcn_s_memrealtime() - t0 > 2000000ull) {
                    if (lane == 0) { unsigned expect = 0u; __hip_atomic_compare_exchange_strong(tmo + 1, &expect, code | (unsigned)(u.pm & 0xff), __ATOMIC_RELAXED, __ATOMIC_RELAXED, __HIP_MEMORY_SCOPE_AGENT);
                                     __hip_atomic_store(tmo, 1u, __ATOMIC_RELAXED, __HIP_MEMORY_SCOPE_AGENT); }
                    dead = true; break; }
                __builtin_amdgcn_s_sleep(2);
            }
            __builtin_amdgcn_fence(__ATOMIC_ACQUIRE, "agent");
            if (lane == 0) flag[0] = dead ? 1u : 0u;
        }
        asm volatile("s_waitcnt vmcnt(0) lgkmcnt(0)" ::: "memory"); __builtin_amdgcn_s_barrier(); asm volatile("" ::: "memory");
        const bool bad = flag[0] != 0u;
        if (lane < 32) {
            const unsigned long long* slot = (const unsigned long long*)xbuf + (size_t)(u.pm * BM + row) * 4; float mt[4], m2[4]; float ms = 0.f;
#pragma unroll
            for (int t = 0; t < 4; ++t) { if (t < ntn) { const unsigned long long w = __hip_atomic_load(slot + t, __ATOMIC_RELAXED, __HIP_MEMORY_SCOPE_AGENT); mt[t] = __uint_as_float((unsigned)w); m2[t] = __uint_as_float((unsigned)(w >> 32)); } else { mt[t] = 0.f; m2[t] = 0.f; } ms += mt[t]; }
            const float mean = ms / (float)ntn; float q = 0.f;
#pragma unroll
            for (int t = 0; t < 4; ++t) if (t < ntn) { const float dm = mt[t] - mean; q += m2[t] + 256.0f * dm * dm; }
            S[row] = (f32x2v){mean, 1.0f / sqrtf(q / (256.0f * (float)ntn) + eps)};
        }
        asm volatile("s_waitcnt lgkmcnt(0)" ::: "memory"); __builtin_amdgcn_s_barrier(); asm volatile("" ::: "memory");
        return bad;
    }
};
struct EpiLnRes {
    static constexpr bool PERM = false, AFTER_DRAIN = true;
    const float* base; float* out; int ldc; const float* bias; PanelStats st; unsigned poison;
    __device__ __forceinline__ void fused(f32x4 (&acc)[2][2][4][2], const Unit& u, int wr, int wc, int fr, int fq, PG8_LAS unsigned char* lds, int wid, int lane) const {
        typedef float f32x2v __attribute__((ext_vector_type(2)));
        const PG8_LAS f32x2v* S = (const PG8_LAS f32x2v*)(lds + 8192);
        const int col0 = u.pn * BM + wc * 32 + 4 * fq;
#pragma unroll
        for (int bj = 0; bj < 2; ++bj)
#pragma unroll
            for (int n = 0; n < 2; ++n) { const f32x4 bv = bias ? *(const f32x4*)(bias + col0 + bj * HALF + n * 16) : (f32x4){0.f, 0.f, 0.f, 0.f};
#pragma unroll
                for (int ai = 0; ai < 2; ++ai)
#pragma unroll
                    for (int m = 0; m < 4; ++m) acc[ai][bj][m][n] += bv; }
        f32x4 pre[4][2][2];
#pragma unroll
        for (int m = 0; m < 4; ++m) { const size_t off = (size_t)(u.pm * BM + wr * 64 + m * 16 + fr) * ldc + col0;
#pragma unroll
            for (int bj = 0; bj < 2; ++bj)
#pragma unroll
                for (int n = 0; n < 2; ++n) pre[m][bj][n] = *(const f32x4*)(base + off + bj * HALF + n * 16); }
        const bool bad = st.run(acc, u, wr, wc, fr, fq, lds, wid, lane) || poison != 0u;
        const float qnan = __builtin_nanf("");
#pragma unroll
        for (int ai = 0; ai < 2; ++ai)
#pragma unroll
            for (int m = 0; m < 4; ++m) { const int r = ai * HALF + wr * 64 + m * 16 + fr; const f32x2v sr = S[r]; const size_t off = (size_t)(u.pm * BM + r) * ldc + col0;
#pragma unroll
                for (int bj = 0; bj < 2; ++bj)
#pragma unroll
                    for (int n = 0; n < 2; ++n) { const f32x4 bs = ai == 0 ? pre[m][bj][n] : *(const f32x4*)(base + off + bj * HALF + n * 16); f32x4 o = bs + (acc[ai][bj][m][n] - sr.x) * sr.y;
                        if (bad) o = (f32x4){qnan, qnan, qnan, qnan}; *(f32x4*)(out + off + bj * HALF + n * 16) = o; }
                if (m & 1) asm volatile("" ::: "memory"); }
    }
};
struct EpiLnResLn {
    static constexpr bool PERM = false, AFTER_DRAIN = true;
    const float* base; float* out; bf16_t* xn; int ldc; const float* bias; PanelStats st1, st2; unsigned poison;
    __device__ __forceinline__ void fused(f32x4 (&acc)[2][2][4][2], const Unit& u, int wr, int wc, int fr, int fq, PG8_LAS unsigned char* lds, int wid, int lane) const {
        typedef float f32x2v __attribute__((ext_vector_type(2))); typedef unsigned u32x2v __attribute__((ext_vector_type(2)));
        const PG8_LAS f32x2v* S = (const PG8_LAS f32x2v*)(lds + 8192);
        const int col0 = u.pn * BM + wc * 32 + 4 * fq;
#pragma unroll
        for (int bj = 0; bj < 2; ++bj)
#pragma unroll
            for (int n = 0; n < 2; ++n) { const f32x4 bv = bias ? *(const f32x4*)(bias + col0 + bj * HALF + n * 16) : (f32x4){0.f, 0.f, 0.f, 0.f};
#pragma unroll
                for (int ai = 0; ai < 2; ++ai)
#pragma unroll
                    for (int m = 0; m < 4; ++m) acc[ai][bj][m][n] += bv; }
        bool bad = st1.run(acc, u, wr, wc, fr, fq, lds, wid, lane) || poison != 0u;
        const float qnan = __builtin_nanf("");
#pragma unroll
        for (int ai = 0; ai < 2; ++ai)
#pragma unroll
            for (int m = 0; m < 4; ++m) { const int r = ai * HALF + wr * 64 + m * 16 + fr; const f32x2v sr = S[r]; const size_t off = (size_t)(u.pm * BM + r) * ldc + col0;
#pragma unroll
                for (int bj = 0; bj < 2; ++bj)
#pragma unroll
                    for (int n = 0; n < 2; ++n) { const f32x4 bs = *(const f32x4*)(base + off + bj * HALF + n * 16); acc[ai][bj][m][n] = bs + (acc[ai][bj][m][n] - sr.x) * sr.y; }
                asm volatile("" : "+v"(acc[ai][0][m][0]), "+v"(acc[ai][0][m][1]), "+v"(acc[ai][1][m][0]), "+v"(acc[ai][1][m][1]));
                if (m & 1) asm volatile("" ::: "memory"); }
        const bool bad1 = bad;
        bad = st2.run(acc, u, wr, wc, fr, fq, lds, wid, lane) || bad;
#pragma unroll
        for (int ai = 0; ai < 2; ++ai)
#pragma unroll
            for (int m = 0; m < 4; ++m) { const int r = ai * HALF + wr * 64 + m * 16 + fr; const f32x2v sr = S[r]; const size_t off = (size_t)(u.pm * BM + r) * ldc + col0;
#pragma unroll
                for (int bj = 0; bj < 2; ++bj)
#pragma unroll
                    for (int n = 0; n < 2; ++n) { const f32x4 x1 = acc[ai][bj][m][n]; *(f32x4*)(out + off + bj * HALF + n * 16) = bad1 ? (f32x4){qnan, qnan, qnan, qnan} : x1;
                        const f32x4 o = (x1 - sr.x) * sr.y; u32x2v w; w.x = cvt_pk_bf16(o[0], o[1]); w.y = cvt_pk_bf16(o[2], o[3]);
                        if (bad) { w.x = 0x7fc07fc0u; w.y = 0x7fc07fc0u; } *(u32x2v*)(xn + off + bj * HALF + n * 16) = w; }
                asm volatile("" ::: "memory"); }
    }
};

template <class Epi, class Sched, bool ALIGN_EPI = false, bool SP2 = false>
__device__ __forceinline__ void gemm_phase(PG8_LAS unsigned char* lds, const Gemm g, const Sched& S, const Epi& E) {
    int tid_ = threadIdx.x; asm volatile("" : "+v"(tid_)); const int tid = tid_, wid = __builtin_amdgcn_readfirstlane(tid >> 6), lane = tid & 63, wr = wid >> 2, wc = wid & 3, fr = lane & 15, fq = lane >> 4;
    const int K = g.K, nt = K / BK;
    unsigned voffA[2], voffB[2];
#pragma unroll
    for (int i = 0; i < 2; ++i) { int R, C; stage_rc(tid * 16 + i * 8192, R, C); const int Rb = Epi::PERM ? ((R & ~31) + perm32(R & 31)) : R;
        voffA[i] = (unsigned)(R * K + C) * 2u; voffB[i] = (unsigned)(Rb * K + C) * 2u; }
    const size_t kstep = (size_t)(BK * 2);
    const size_t hstep = (size_t)HALF * K * 2;
    const size_t tstep = 2 * hstep;
    const unsigned ldsw = (unsigned)wid * 1024u;
    const int aoff = lds_byte(wr * 64 + fr, fq * 8), boff = lds_byte(wc * 32 + fr, fq * 8);
#define PG8_SA(b, h) (((b) * 2 + (h)) * HTB)
#define PG8_SB(b, h) ((4 + (b) * 2 + (h)) * HTB)
#define PG8_STAGE(bufoff, gbase, voff) do { _Pragma("unroll") for (int _i = 0; _i < 2; ++_i) \
        __builtin_amdgcn_global_load_lds((const unsigned*)((const char*)(gbase) + (voff)[_i]), (PG8_LAS unsigned*)(lds + (bufoff) + ldsw + _i * 8192), 16, 0, 0); } while (0)
#define PG8_LDA(dst, b, h) do { _Pragma("unroll") for (int m = 0; m < 4; ++m) _Pragma("unroll") for (int k = 0; k < 2; ++k) dst[m][k] = *(const PG8_LAS bf16x8*)(lds + PG8_SA(b, h) + aoff + m * 2048 + k * 1024); } while (0)
#define PG8_LDB(dst, b, h) do { _Pragma("unroll") for (int n = 0; n < 2; ++n) _Pragma("unroll") for (int k = 0; k < 2; ++k) dst[n][k] = *(const PG8_LAS bf16x8*)(lds + PG8_SB(b, h) + boff + n * 2048 + k * 1024); } while (0)
#define PG8_MMA(ai, bj, At, Bt) do { __builtin_amdgcn_s_setprio(1); _Pragma("unroll") for (int m = 0; m < 4; ++m) _Pragma("unroll") for (int n = 0; n < 2; ++n) _Pragma("unroll") for (int k = 0; k < 2; ++k) \
        acc[ai][bj][m][n] = __builtin_amdgcn_mfma_f32_16x16x32_bf16(Bt[n][k], At[m][k], acc[ai][bj][m][n], 0, 0, 0); __builtin_amdgcn_s_setprio(0); } while (0)
#define PG8_WAIT_V(n) asm volatile("s_waitcnt vmcnt(" #n ")" ::: "memory")
#define PG8_WAIT_L(n) asm volatile("s_waitcnt lgkmcnt(" #n ")" ::: "memory")
#define PG8_BAR __builtin_amdgcn_s_barrier()
#define PG8_SCHED __builtin_amdgcn_sched_barrier(0)
    Unit cur, nxt; int ui = 0;
    if (!S.next(0, cur)) return;
    f32x4 acc[2][2][4][2];
#pragma unroll
    for (int a = 0; a < 2; ++a)
#pragma unroll
        for (int b = 0; b < 2; ++b)
#pragma unroll
            for (int m = 0; m < 4; ++m)
#pragma unroll
                for (int n = 0; n < 2; ++n) acc[a][b][m][n] = (f32x4){0.f, 0.f, 0.f, 0.f};
    bf16x8 At[4][2], B0[2][2], B1[2][2];
    const char* cA = (const char*)g.A + (size_t)cur.pm * tstep; const char* cB = (const char*)g.Bt + (size_t)cur.pn * tstep;
    S.a_ready(cur);
    if constexpr (SP2) {
        PG8_STAGE(PG8_SB(0, 0), cB, voffB); PG8_STAGE(PG8_SB(0, 1), cB + hstep, voffB); PG8_STAGE(PG8_SA(0, 0), cA, voffA); PG8_STAGE(PG8_SA(0, 1), cA + hstep, voffA);
        if (wr == 1) PG8_BAR;
        PG8_WAIT_V(2); PG8_BAR;
        PG8_STAGE(PG8_SB(1, 0), cB + kstep, voffB); PG8_STAGE(PG8_SA(1, 0), cA + kstep, voffA); PG8_STAGE(PG8_SB(1, 1), cB + hstep + kstep, voffB);
        PG8_WAIT_V(6); PG8_BAR;
    } else {
        PG8_STAGE(PG8_SB(0, 0), cB, voffB); PG8_STAGE(PG8_SA(0, 0), cA, voffA); PG8_STAGE(PG8_SB(0, 1), cB + hstep, voffB); PG8_STAGE(PG8_SA(0, 1), cA + hstep, voffA);
        if (wr == 1) PG8_BAR;
        PG8_WAIT_V(4); PG8_BAR;
        PG8_STAGE(PG8_SB(1, 0), cB + kstep, voffB); PG8_STAGE(PG8_SA(1, 0), cA + kstep, voffA); PG8_STAGE(PG8_SB(1, 1), cB + hstep + kstep, voffB);
        PG8_WAIT_V(6); PG8_BAR;
    }
    for (;;) {
        const bool has_next = S.next(ui + 1, nxt);
        const char* nA = has_next ? (const char*)g.A + (size_t)nxt.pm * tstep : cA; const char* nB = has_next ? (const char*)g.Bt + (size_t)nxt.pn * tstep : cB;
        for (int t = 0; t < nt; t += 2) {
            const bool last = (t == nt - 2);
            const char* a1 = cA + (size_t)(t + 1) * kstep;
            const char* a2 = last ? nA : cA + (size_t)(t + 2) * kstep; const char* b2 = last ? nB : cB + (size_t)(t + 2) * kstep;
            const char* a3 = a2 + kstep; const char* b3 = b2 + kstep;
            if (last && has_next) S.a_ready(nxt);
            if constexpr (SP2) {
            PG8_LDB(B0, 0, 0); PG8_LDB(B1, 0, 1); PG8_SCHED; PG8_LDA(At, 0, 0); PG8_STAGE(PG8_SA(1, 1), a1 + hstep, voffA);
            PG8_WAIT_V(8); PG8_WAIT_L(0); PG8_BAR; PG8_MMA(0, 0, At, B0); PG8_MMA(0, 1, At, B1); PG8_BAR; PG8_SCHED;
            PG8_LDA(At, 0, 1); PG8_STAGE(PG8_SB(0, 0), b2, voffB); PG8_STAGE(PG8_SB(0, 1), b2 + hstep, voffB); PG8_STAGE(PG8_SA(0, 0), a2, voffA);
            PG8_WAIT_V(8); PG8_WAIT_L(0); PG8_BAR; PG8_MMA(1, 0, At, B0); PG8_MMA(1, 1, At, B1); PG8_BAR; PG8_SCHED;
            PG8_LDB(B0, 1, 0); PG8_LDB(B1, 1, 1); PG8_SCHED; PG8_LDA(At, 1, 0); PG8_STAGE(PG8_SA(0, 1), a2 + hstep, voffA);
            PG8_WAIT_V(8); PG8_WAIT_L(0); PG8_BAR; PG8_MMA(0, 0, At, B0); PG8_MMA(0, 1, At, B1); PG8_BAR; PG8_SCHED;
            PG8_LDA(At, 1, 1); PG8_STAGE(PG8_SB(1, 0), b3, voffB); PG8_STAGE(PG8_SB(1, 1), b3 + hstep, voffB); PG8_STAGE(PG8_SA(1, 0), a3, voffA);
            PG8_WAIT_V(8); PG8_WAIT_L(0); PG8_BAR; PG8_MMA(1, 0, At, B0); PG8_MMA(1, 1, At, B1); PG8_BAR; PG8_SCHED;
            } else {
            PG8_LDB(B0, 0, 0); PG8_SCHED; PG8_LDA(At, 0, 0); PG8_STAGE(PG8_SA(1, 1), a1 + hstep, voffA);
            PG8_WAIT_L(8); PG8_BAR; PG8_WAIT_L(0); PG8_MMA(0, 0, At, B0); PG8_BAR; PG8_SCHED;
            PG8_LDB(B1, 0, 1); PG8_STAGE(PG8_SB(0, 0), b2, voffB);
            PG8_BAR; PG8_WAIT_L(0); PG8_MMA(0, 1, At, B1); PG8_BAR;
            PG8_LDA(At, 0, 1); PG8_STAGE(PG8_SA(0, 0), a2, voffA);
            PG8_BAR; PG8_WAIT_L(0); PG8_MMA(1, 0, At, B0); PG8_BAR; PG8_SCHED;
            PG8_STAGE(PG8_SB(0, 1), b2 + hstep, voffB);
            PG8_WAIT_V(6); PG8_BAR; PG8_MMA(1, 1, At, B1); PG8_BAR;
            PG8_LDB(B0, 1, 0); PG8_SCHED; PG8_LDA(At, 1, 0); PG8_STAGE(PG8_SA(0, 1), a2 + hstep, voffA);
            PG8_WAIT_L(8); PG8_BAR; PG8_WAIT_L(0); PG8_MMA(0, 0, At, B0); PG8_BAR; PG8_SCHED;
            PG8_LDB(B1, 1, 1); PG8_STAGE(PG8_SB(1, 0), b3, voffB);
            PG8_BAR; PG8_WAIT_L(0); PG8_MMA(0, 1, At, B1); PG8_BAR;
            PG8_LDA(At, 1, 1); PG8_STAGE(PG8_SA(1, 0), a3, voffA);
            PG8_BAR; PG8_WAIT_L(0); PG8_MMA(1, 0, At, B0); PG8_BAR; PG8_SCHED;
            PG8_STAGE(PG8_SB(1, 1), b3 + hstep, voffB);
            PG8_WAIT_V(6); PG8_BAR; PG8_MMA(1, 1, At, B1); PG8_BAR;
            }
        }
        if constexpr (ALIGN_EPI) { if (wr == 0) PG8_BAR; }
        if constexpr (!Epi::AFTER_DRAIN) { E(acc, cur, wr, wc, fr, fq); S.done(cur); }
        if (!has_next) break;
#pragma unroll
        for (int a = 0; a < 2; ++a)
#pragma unroll
            for (int b = 0; b < 2; ++b)
#pragma unroll
                for (int m = 0; m < 4; ++m)
#pragma unroll
                    for (int n = 0; n < 2; ++n) acc[a][b][m][n] = (f32x4){0.f, 0.f, 0.f, 0.f};
        cur = nxt; cA = nA; cB = nB; ++ui;
        if constexpr (ALIGN_EPI) { if (wr == 1) PG8_BAR; }
    }
    PG8_WAIT_V(0);
    if constexpr (!ALIGN_EPI) { if (wr == 0) PG8_BAR; }
    PG8_BAR;
    if constexpr (Epi::AFTER_DRAIN) { E.fused(acc, cur, wr, wc, fr, fq, lds, wid, lane); S.done(cur); }
#undef PG8_SA
#undef PG8_SB
#undef PG8_STAGE
#undef PG8_LDA
#undef PG8_LDB
#undef PG8_MMA
#undef PG8_WAIT_V
#undef PG8_WAIT_L
#undef PG8_BAR
#undef PG8_SCHED
}
}
namespace cg = cooperative_groups;
#define GAS __attribute__((address_space(1)))
#define LAS __attribute__((address_space(3)))
typedef unsigned short bf16;
typedef unsigned v4u __attribute__((ext_vector_type(4)));
typedef unsigned v2u __attribute__((ext_vector_type(2)));
typedef float f32x4 __attribute__((ext_vector_type(4)));
typedef short bf16x8 __attribute__((ext_vector_type(8)));

constexpr int NB = 8, SEQ = 2048, DM = 1024, DEPTH = 4, MTOK = NB * SEQ;
constexpr int INC = 9216, ADAC = 3072, MIXW = 2048;
constexpr int C_QH = 0, C_IH = 1024, C_ZFW = 2048, C_ZBW = 3072, C_GH = 4096, C_QN = 5120, C_KN = 6144, C_VN = 7168, C_GN = 8192;
constexpr float DN_ALPHA = 1.6817928305074290f;
constexpr float LN_EPS = 1e-5f, RMS_EPS = 1e-6f;

constexpr size_t MiB = 1u << 20;
constexpr size_t WS_CTL = 0, CTL_ZERO_BYTES = 1 * MiB;
constexpr size_t WS_MOD = 1 * MiB;
constexpr size_t WS_LB = 1 * MiB + 512 * 1024;
constexpr size_t WS_WTIN = 2 * MiB;
constexpr size_t WS_WTOUT = 74 * MiB;
constexpr size_t WS_H = 90 * MiB;
constexpr size_t WS_P = 122 * MiB;
constexpr size_t WS_Y = 410 * MiB;
constexpr size_t WS_OBUF = 474 * MiB;
constexpr size_t WS_OB2 = 538 * MiB;
constexpr size_t WS_END = 570 * MiB;
constexpr int CW_HG = 1024;

constexpr int LDS_BYTES = 155648;
constexpr int LDS_FLAG = 155648 - 64;
constexpr int NPHASE = 2 + 4 * DEPTH;

__device__ __forceinline__ float bf2f(bf16 v) { return __uint_as_float((unsigned)v << 16); }
__device__ __forceinline__ unsigned f2bf(float f) { unsigned u = __float_as_uint(f); return (u + 0x7fffu + ((u >> 16) & 1u)) >> 16; }
__device__ __forceinline__ unsigned pk2(float lo, float hi) { return f2bf(lo) | (f2bf(hi) << 16); }
__device__ __forceinline__ float wave_sum(float v) {
#pragma unroll
    for (int o = 1; o < 64; o <<= 1) v += __shfl_xor(v, o);
    return v;
}
__device__ __forceinline__ float wave_max(float v) {
#pragma unroll
    for (int o = 1; o < 64; o <<= 1) v = fmaxf(v, __shfl_xor(v, o));
    return v;
}
__device__ __forceinline__ float sigmoidf_(float z) { return 1.0f / (1.0f + __expf(-z)); }

struct Args { const float* in[11]; float* out; unsigned char* ws; int ph_lo, ph_hi, coop, pad; };

__device__ __forceinline__ void p0_transpose_item(const float* W, int K, int N, bf16* WT, LAS float* scr, int item, int lane) {
    const int nblk = N / 32, kb = item / nblk, nb = item % nblk, k0 = 64 * kb, n0 = 32 * nb;
#pragma unroll 8
    for (int i = 0; i < 32; ++i) { const int kk = 2 * i + (lane >> 5); scr[kk * 33 + (lane & 31)] = W[(size_t)(k0 + kk) * N + n0 + (lane & 31)]; }
    asm volatile("s_waitcnt lgkmcnt(0)" ::: "memory");
    const int c = lane & 7;
#pragma unroll
    for (int j = 0; j < 4; ++j) { const int n = (lane >> 3) + 8 * j; const LAS float* s = scr + (8 * c) * 33 + n;
        v4u o; o.x = pk2(s[0 * 33], s[1 * 33]); o.y = pk2(s[2 * 33], s[3 * 33]); o.z = pk2(s[4 * 33], s[5 * 33]); o.w = pk2(s[6 * 33], s[7 * 33]);
        *(v4u*)(WT + (size_t)(n0 + n) * K + k0 + 8 * c) = o; }
    asm volatile("s_waitcnt lgkmcnt(0)" ::: "memory");
}

struct EpiZ {
    static constexpr bool PERM = false, AFTER_DRAIN = false;
    const float* xin; float* out; const float* gate;
    __device__ __forceinline__ void operator()(const pg8::f32x4 (&acc)[2][2][4][2], const pg8::Unit& u, int wr, int wc, int fr, int fq) const {
        const int col0 = u.pn * 256 + wc * 32 + 4 * fq;
        const float* g = gate + (size_t)(u.pm >> 3) * ADAC;
#pragma unroll
        for (int ai = 0; ai < 2; ++ai)
#pragma unroll
            for (int m = 0; m < 4; ++m) { const size_t r = (size_t)u.pm * 256 + ai * 128 + wr * 64 + m * 16 + fr;
#pragma unroll
                for (int bj = 0; bj < 2; ++bj)
#pragma unroll
                    for (int n = 0; n < 2; ++n) { const int c = col0 + bj * 128 + n * 16;
                        const f32x4 g4 = *(const f32x4*)(g + c); const f32x4 xv = *(const f32x4*)(xin + r * DM + c);
                        const pg8::f32x4 av = acc[ai][bj][m][n];
                        f32x4 o; o.x = DN_ALPHA * xv.x + g4.x * av[0]; o.y = DN_ALPHA * xv.y + g4.y * av[1]; o.z = DN_ALPHA * xv.z + g4.z * av[2]; o.w = DN_ALPHA * xv.w + g4.w * av[3];
                        *(f32x4*)(out + r * DM + c) = o; } }
    }
};

struct Ctx {
    LAS unsigned char* lds; int tid, lane, wave;
    const Args* a;
    __device__ __forceinline__ const float* in(int k) const { return a->in[k]; }
    __device__ __forceinline__ unsigned char* wsp() const { return a->ws; }
#define CTXP(name, expr) __device__ __forceinline__ auto name() const { return expr; }
    CTXP(x, in(0)) CTXP(c, in(1)) CTXP(ada_w, in(2)) CTXP(ada_b, in(3)) CTXP(w_in, in(4)) CTXP(lb_logits, in(5)) CTXP(hg_norm_g, in(6))
    CTXP(rpb, in(7)) CTXP(w_out, in(8)) CTXP(ln_g, in(9)) CTXP(ln_b, in(10)) CTXP(out, a->out)
    CTXP(mod, (float*)(wsp() + WS_MOD)) CTXP(lb, (float*)(wsp() + WS_LB)) CTXP(wt_in, (bf16*)(wsp() + WS_WTIN)) CTXP(wt_out, (bf16*)(wsp() + WS_WTOUT))
    CTXP(H, (bf16*)(wsp() + WS_H)) CTXP(P, (bf16*)(wsp() + WS_P)) CTXP(Y, (bf16*)(wsp() + WS_Y)) CTXP(obuf, (float*)(wsp() + WS_OBUF))
#undef CTXP
};

__device__ __forceinline__ void phase_prologue(Ctx& F) {
    LAS float* scr = (LAS float*)(F.lds + F.wave * 16384);
    const int gw = blockIdx.x * 8 + F.wave, NGW = gridDim.x * 8;
    constexpr int I_IN = (DM / 64) * (INC / 32), I_OUT = (MIXW / 64) * (DM / 32);
    for (int it = gw; it < DEPTH * (I_IN + I_OUT); it += NGW) {
        int l = it / (I_IN + I_OUT), r = it % (I_IN + I_OUT);
        if (r < I_IN) p0_transpose_item(F.w_in() + (size_t)l * DM * INC, DM, INC, F.wt_in() + (size_t)l * INC * DM, scr, r, F.lane);
        else p0_transpose_item(F.w_out() + (size_t)l * MIXW * DM, MIXW, DM, F.wt_out() + (size_t)l * DM * MIXW, scr, r - I_IN, F.lane);
    }
    __syncthreads();
    LAS float* sc = (LAS float*)F.lds;
    LAS float* red = (LAS float*)(F.lds + 32768);
    for (int it = blockIdx.x; it < DEPTH * (ADAC / 64); it += gridDim.x) {
        const int l = it / (ADAC / 64), j0 = (it % (ADAC / 64)) * 64;
        for (int i = F.tid; i < NB * DM; i += 512) { const float v = F.c()[i]; sc[i] = v * sigmoidf_(v); }
        __syncthreads();
        const int kq = F.tid >> 6, jj = F.tid & 63;
        float acc[8];
#pragma unroll
        for (int b = 0; b < 8; ++b) acc[b] = 0.f;
        const float* w = F.ada_w() + (size_t)l * DM * ADAC + j0 + jj;
#pragma unroll 8
        for (int k = kq; k < DM; k += 8) { const float wv = w[(size_t)k * ADAC];
#pragma unroll
            for (int b = 0; b < 8; ++b) acc[b] += sc[b * DM + k] * wv; }
#pragma unroll
        for (int b = 0; b < 8; ++b) red[(kq * 8 + b) * 64 + jj] = acc[b];
        __syncthreads();
        { const int b = F.tid >> 6; float s = 0.f;
#pragma unroll
          for (int q = 0; q < 8; ++q) s += red[(q * 8 + b) * 64 + jj];
          F.mod()[((size_t)l * NB + b) * ADAC + j0 + jj] = s + F.ada_b()[l * ADAC + j0 + jj]; }
        __syncthreads();
    }
    if (blockIdx.x == 0) { unsigned* ctl = (unsigned*)(F.wsp() + WS_CTL); for (int i = F.tid; i < DEPTH * 64; i += 512) ctl[CW_HG + i * 64] = 0u; }
    if (blockIdx.x == gridDim.x - 1) {
        for (int i = F.tid; i < 2 * 1024; i += 512) { const int ds = i >> 10, ch = i & 1023;
            float lg[4], mx = -1e30f;
#pragma unroll
            for (int l = 0; l < 4; ++l) { lg[l] = F.lb_logits()[(ds * 4 + l) * 1024 + ch]; mx = fmaxf(mx, lg[l]); }
            float s = 0.f;
#pragma unroll
            for (int l = 0; l < 4; ++l) { lg[l] = __expf(lg[l] - mx); s += lg[l]; }
            const float inv = 1.f / s; float cs = 0.f;
            F.lb()[(ds * 4 + 0) * 1024 + ch] = 0.f;
#pragma unroll
            for (int l = 1; l < 4; ++l) { cs += lg[l] * inv; F.lb()[(ds * 4 + l) * 1024 + ch] = cs; }
        }
    }
}

__device__ __forceinline__ void ln_mod_row(const float* xrow, const float* modb  , bf16* orow, int lane) {
    const f32x4* xr = (const f32x4*)xrow + lane;
    f32x4 v[4]; float s = 0.f;
#pragma unroll
    for (int j = 0; j < 4; ++j) { v[j] = xr[64 * j]; s += (v[j].x + v[j].y) + (v[j].z + v[j].w); }
    const float mean = wave_sum(s) * (1.f / DM); float s2 = 0.f;
#pragma unroll
    for (int j = 0; j < 4; ++j) { v[j] = v[j] - mean; s2 += (v[j].x * v[j].x + v[j].y * v[j].y) + (v[j].z * v[j].z + v[j].w * v[j].w); }
    const float rstd = 1.f / sqrtf(wave_sum(s2) * (1.f / DM) + LN_EPS);
    unsigned long long* o8 = (unsigned long long*)orow + lane;
#pragma unroll
    for (int j = 0; j < 4; ++j) { const f32x4 sh = *((const f32x4*)modb + lane + 64 * j), sc = *((const f32x4*)(modb + DM) + lane + 64 * j);
        const float a = v[j].x * rstd * (1.f + sc.x) + sh.x, b = v[j].y * rstd * (1.f + sc.y) + sh.y, c = v[j].z * rstd * (1.f + sc.z) + sh.z, d = v[j].w * rstd * (1.f + sc.w) + sh.w;
        o8[64 * j] = (unsigned long long)pk2(a, b) | ((unsigned long long)pk2(c, d) << 32); }
}
__device__ __forceinline__ void phase_ln0(Ctx& F) {
    const int gw = blockIdx.x * 8 + F.wave, NGW = gridDim.x * 8;
    for (int m = gw; m < MTOK; m += NGW) ln_mod_row(F.x() + (size_t)m * DM, F.mod() + (size_t)(0 * NB + (m >> 11)) * ADAC, F.H() + (size_t)m * DM, F.lane);
}
__device__ __forceinline__ void phase_ln(Ctx& F, int l) {
    const int gw = blockIdx.x * 8 + F.wave, NGW = gridDim.x * 8;
    for (int m = gw; m < MTOK; m += NGW) {
        f32x4* xr = (f32x4*)(F.out() + (size_t)m * DM) + F.lane;
        f32x4 v[4]; float s = 0.f;
#pragma unroll
        for (int j = 0; j < 4; ++j) { v[j] = xr[64 * j]; s += (v[j].x + v[j].y) + (v[j].z + v[j].w); }
        const float mean = wave_sum(s) * (1.f / DM); float s2 = 0.f;
#pragma unroll
        for (int j = 0; j < 4; ++j) { v[j] = v[j] - mean; s2 += (v[j].x * v[j].x + v[j].y * v[j].y) + (v[j].z * v[j].z + v[j].w * v[j].w); }
        const float rstd = 1.f / sqrtf(wave_sum(s2) * (1.f / DM) + LN_EPS);
        float t = 0.f;
#pragma unroll
        for (int j = 0; j < 4; ++j) { const f32x4 g = *((const f32x4*)(F.ln_g() + l * DM) + F.lane + 64 * j), b = *((const f32x4*)(F.ln_b() + l * DM) + F.lane + 64 * j);
            v[j].x = v[j].x * rstd * g.x + b.x; v[j].y = v[j].y * rstd * g.y + b.y; v[j].z = v[j].z * rstd * g.z + b.z; v[j].w = v[j].w * rstd * g.w + b.w;
            xr[64 * j] = v[j]; t += (v[j].x + v[j].y) + (v[j].z + v[j].w); }
        if (l + 1 < DEPTH) {
            const float mean2 = wave_sum(t) * (1.f / DM); float t2 = 0.f;
#pragma unroll
            for (int j = 0; j < 4; ++j) { v[j] = v[j] - mean2; t2 += (v[j].x * v[j].x + v[j].y * v[j].y) + (v[j].z * v[j].z + v[j].w * v[j].w); }
            const float rstd2 = 1.f / sqrtf(wave_sum(t2) * (1.f / DM) + LN_EPS);
            const float* modb = F.mod() + (size_t)((l + 1) * NB + (m >> 11)) * ADAC;
            unsigned long long* o8 = (unsigned long long*)(F.H() + (size_t)m * DM) + F.lane;
#pragma unroll
            for (int j = 0; j < 4; ++j) { const f32x4 sh = *((const f32x4*)modb + F.lane + 64 * j), sc = *((const f32x4*)(modb + DM) + F.lane + 64 * j);
                const float a = v[j].x * rstd2 * (1.f + sc.x) + sh.x, b = v[j].y * rstd2 * (1.f + sc.y) + sh.y, c = v[j].z * rstd2 * (1.f + sc.z) + sh.z, d = v[j].w * rstd2 * (1.f + sc.w) + sh.w;
                o8[64 * j] = (unsigned long long)pk2(a, b) | ((unsigned long long)pk2(c, d) << 32); }
        }
    }
}

__device__ __forceinline__ void hgrn_naive_unit(Ctx& F, int l, int bh) {
    const int b = bh >> 3, h = bh & 7, tid = F.tid;
    const bf16* Pb = F.P() + (size_t)b * SEQ * INC;
    LAS float* sq = (LAS float*)F.lds;
    LAS float* sf = sq + 16 * 128;
    LAS float* sk = sf + 16 * 128;
    LAS float* so = sk + 16 * 128;
    LAS float* srs = so + 16 * 128;
    const bool act = tid < 128;
    const int ch = h * 128 + (tid & 127);
    const float ng = F.hg_norm_g()[l * 128 + (tid & 127)];
    for (int pass = 1; pass >= 0; --pass) {
        float S[128];
#pragma unroll
        for (int d = 0; d < 128; ++d) S[d] = 0.f;
        const float lbv = F.lb()[(pass * 4 + l) * 1024 + ch];
        const int zc = pass ? C_ZBW : C_ZFW;
        for (int c = 0; c < SEQ / 16; ++c) {
            if (act) {
#pragma unroll 4
                for (int i = 0; i < 16; ++i) { const int tt = c * 16 + i, tok = pass ? (SEQ - 1 - tt) : tt; const bf16* row = Pb + (size_t)tok * INC;
                    const float q = bf2f(row[C_QH + ch]), z = bf2f(row[zc + ch]);
                    const float f = lbv + (1.f - lbv) * sigmoidf_(z);
                    sq[i * 128 + tid] = q; sf[i * 128 + tid] = f; sk[i * 128 + tid] = 1.f - f; }
            }
            __syncthreads();
            if (act) {
                for (int i = 0; i < 16; ++i) { const int tt = c * 16 + i, tok = pass ? (SEQ - 1 - tt) : tt; const bf16* row = Pb + (size_t)tok * INC;
                    const float vt = bf2f(row[C_IH + ch]); float o = 0.f;
#pragma unroll
                    for (int d = 0; d < 128; ++d) { S[d] = sf[i * 128 + d] * S[d] + sk[i * 128 + d] * vt; o += sq[i * 128 + d] * S[d]; }
                    float* op = F.obuf() + ((size_t)b * SEQ + tok) * 1024 + ch;
                    if (pass) *op = o; else so[i * 128 + tid] = o + *op; }
            }
            __syncthreads();
            if (pass == 0) {
                if (tid < 16) { float ss = 0.f; for (int d = 0; d < 128; ++d) { const float v = so[tid * 128 + d]; ss += v * v; } srs[tid] = 1.f / sqrtf(ss * (1.f / 128.f) + RMS_EPS); }
                __syncthreads();
                if (act) { for (int i = 0; i < 16; ++i) { const int tok = c * 16 + i; const bf16* row = Pb + (size_t)tok * INC;
                        const float g = bf2f(row[C_GH + ch]); const float y = so[i * 128 + tid] * srs[i] * ng * (g * sigmoidf_(g));
                        F.Y()[((size_t)b * SEQ + tok) * MIXW + ch] = (bf16)f2bf(y); } }
                __syncthreads();
            }
        }
    }
}
__device__ __forceinline__ void na_naive_items(Ctx& F, int l) {
    LAS float* sp = (LAS float*)(F.lds + 65536) + F.wave * 128;
    const int lane = F.lane;
    for (int it0 = blockIdx.x * 8; it0 < MTOK * 16; it0 += gridDim.x * 8) {
        const int it = it0 + F.wave;
        const int tokq = it >> 4, h = it & 15, b = tokq >> 11, r = (tokq >> 6) & 31, col = tokq & 63;
        const int rs = min(max(r - 4, 0), 24), cs = min(max(col - 8, 0), 48);
        const bf16* qrow = F.P() + (size_t)tokq * INC + C_QN + h * 64;
        float s2[2];
#pragma unroll
        for (int e = 0; e < 2; ++e) { const int kk = lane + 64 * e, kr = kk >> 4, kc = kk & 15; const int tokk = b * SEQ + (rs + kr) * 64 + cs + kc;
            const bf16* krow = F.P() + (size_t)tokk * INC + C_KN + h * 64; float dot = 0.f;
#pragma unroll
            for (int d8 = 0; d8 < 8; ++d8) { const v4u qa = *(const v4u*)(qrow + d8 * 8), ka = *(const v4u*)(krow + d8 * 8);
#pragma unroll
                for (int w = 0; w < 4; ++w) { dot += __uint_as_float(qa[w] << 16) * __uint_as_float(ka[w] << 16) + __uint_as_float(qa[w] & 0xffff0000u) * __uint_as_float(ka[w] & 0xffff0000u); } }
            const float bias = F.rpb()[(((size_t)l * 16 + h) * 15 + (rs + kr - r + 7)) * 31 + (cs + kc - col + 15)];
            s2[e] = dot * 0.125f + bias; }
        const float mx = wave_max(fmaxf(s2[0], s2[1]));
        const float p0 = __expf(s2[0] - mx), p1 = __expf(s2[1] - mx);
        const float sum = wave_sum(p0 + p1);
        sp[lane] = p0; sp[lane + 64] = p1;
        asm volatile("s_waitcnt lgkmcnt(0)" ::: "memory");
        float o = 0.f;
        for (int kk = 0; kk < 128; ++kk) { const int kr = kk >> 4, kc = kk & 15; const int tokk = b * SEQ + (rs + kr) * 64 + cs + kc;
            o += sp[kk] * bf2f(F.P()[(size_t)tokk * INC + C_VN + h * 64 + lane]); }
        const float g = bf2f(F.P()[(size_t)tokq * INC + C_GN + h * 64 + lane]);
        F.Y()[(size_t)tokq * MIXW + 1024 + h * 64 + lane] = (bf16)f2bf(o / sum * (g * sigmoidf_(g)));
        asm volatile("s_waitcnt lgkmcnt(0)" ::: "memory");
    }
}
__device__ __forceinline__ void phase_mix_naive(Ctx& F, int l) {
    for (int u = blockIdx.x; u < 64; u += gridDim.x) hgrn_naive_unit(F, l, u);
    __syncthreads();
    na_naive_items(F, l);
}


typedef float hf32x4 __attribute__((ext_vector_type(4)));
constexpr int HG_RS = 272, HG_TS = 80;
constexpr int HG_QM = 0, HG_KM = 8704, HG_KMT = 17408, HG_VT = 27648, HG_C = 37888, HG_A = 38912, HG_CHUNK = 41472;
__device__ __forceinline__ float* hg_obw(Ctx& F, int b) { return b < 4 ? (float*)(F.wsp() + WS_H) + (size_t)b * SEQ * 1024 : (float*)(F.wsp() + WS_OB2) + (size_t)(b - 4) * SEQ * 1024; }
__device__ __forceinline__ bf16x8 ld_frag(LAS unsigned char* p) { return *(LAS bf16x8*)p; }
#define MFMA16(a, b, c) __builtin_amdgcn_mfma_f32_16x16x32_bf16((a), (b), (c), 0, 0, 0)

__device__ __forceinline__ void hgrn_unit(Ctx& F, int l, int unit) {
    const int dir = unit & 1, bh = unit >> 1, b = bh >> 3, h = bh & 7;
    const int lane = F.lane, wv = F.wave;
    LAS unsigned char* L = F.lds;
    const bf16* Pb = F.P() + (size_t)b * SEQ * INC;
    float* Ob = dir ? hg_obw(F, b) : F.obuf() + (size_t)b * SEQ * 1024;
    const int par = wv >> 2, cpg = (wv >> 1) & 1, qp = wv & 1;
    const int cp = 32 * cpg + (lane & 31), quarter = 2 * qp + (lane >> 5), t0 = 8 * quarter;
    const int ci = cp & 15, grp = cp >> 4;
    const int pi = (((ci >> 1) & 3) << 2) | (((ci >> 3) & 1) << 1) | (ci & 1);
    const int chA = h * 128 + 2 * cp;
    const float lb0 = F.lb()[(dir * 4 + l) * 1024 + chA], lb1 = F.lb()[(dir * 4 + l) * 1024 + chA + 1];
    const int zc = dir ? C_ZBW : C_ZFW;
    LAS unsigned char* Lp = L + par * HG_CHUNK;
    const int fr = lane & 15, g = lane >> 4;
    unsigned rq[8], rz[8], rv[8];
#define HG_LOAD_RAW(R) do { _Pragma("unroll") for (int i = 0; i < 8; ++i) { const int p_ = 32 * (2 * (R) + par) + t0 + i; const int tok_ = dir ? (SEQ - 1 - p_) : p_; \
        const bf16* row_ = Pb + (size_t)tok_ * INC + chA; rq[i] = *(const unsigned*)(row_ + C_QH); rz[i] = *(const unsigned*)(row_ + zc); rv[i] = *(const unsigned*)(row_ + C_IH); } } while (0)
    HG_LOAD_RAW(0);
    hf32x4 T[8];
#pragma unroll
    for (int mt = 0; mt < 8; ++mt) T[mt] = (hf32x4){0.f, 0.f, 0.f, 0.f};
    for (int R = 0; R < SEQ / 64; ++R) {
        {
            float qm[2][8], km[2][8]; float tot[2];
#pragma unroll
            for (int e = 0; e < 2; ++e) {
                const float lbe = e ? lb1 : lb0;
                float q[8], f[8], k[8];
#pragma unroll
                for (int i = 0; i < 8; ++i) { q[i] = e ? __uint_as_float(rq[i] & 0xffff0000u) : __uint_as_float(rq[i] << 16);
                    const float z = e ? __uint_as_float(rz[i] & 0xffff0000u) : __uint_as_float(rz[i] << 16);
                    const float sg = sigmoidf_(z); f[i] = lbe + (1.f - lbe) * sg; k[i] = 1.f - f[i]; }
                if (qp == 0) {
                    float Rl[8]; Rl[7] = 1.f;
#pragma unroll
                    for (int i = 6; i >= 0; --i) Rl[i] = Rl[i + 1] * f[i + 1];
                    const float tt = Rl[0] * f[0]; const float oth = __shfl_xor(tt, 32); const float mult = (lane < 32) ? oth : 1.f;
#pragma unroll
                    for (int i = 0; i < 8; ++i) { const float Rv = Rl[i] * mult; qm[e][i] = q[i] * __builtin_amdgcn_rcpf(Rv); km[e][i] = k[i] * Rv; }
                    tot[e] = tt * oth;
                } else {
                    float El[8]; El[0] = f[0];
#pragma unroll
                    for (int i = 1; i < 8; ++i) El[i] = El[i - 1] * f[i];
                    const float tt = El[7]; const float oth = __shfl_xor(tt, 32); const float mult = (lane >= 32) ? oth : 1.f;
#pragma unroll
                    for (int i = 0; i < 8; ++i) { const float Ev = El[i] * mult; qm[e][i] = q[i] * Ev; km[e][i] = k[i] * __builtin_amdgcn_rcpf(Ev); }
                    tot[e] = tt * oth;
                }
            }
#pragma unroll
            for (int i = 0; i < 8; ++i) {
                *(LAS unsigned*)(Lp + HG_QM + (t0 + i) * HG_RS + (grp * 16 + pi) * 4) = pk2(qm[0][i], qm[1][i]);
                *(LAS unsigned*)(Lp + HG_KM + (t0 + i) * HG_RS + (grp * 16 + pi) * 4) = pk2(km[0][i], km[1][i]);
            }
#pragma unroll
            for (int e = 0; e < 2; ++e) {
                v4u kk, vv;
                kk.x = pk2(km[e][0], km[e][1]); kk.y = pk2(km[e][2], km[e][3]); kk.z = pk2(km[e][4], km[e][5]); kk.w = pk2(km[e][6], km[e][7]);
                if (e == 0) { vv.x = (rv[0] & 0xffffu) | (rv[1] << 16); vv.y = (rv[2] & 0xffffu) | (rv[3] << 16); vv.z = (rv[4] & 0xffffu) | (rv[5] << 16); vv.w = (rv[6] & 0xffffu) | (rv[7] << 16); }
                else        { vv.x = (rv[0] >> 16) | (rv[1] & 0xffff0000u); vv.y = (rv[2] >> 16) | (rv[3] & 0xffff0000u); vv.z = (rv[4] >> 16) | (rv[5] & 0xffff0000u); vv.w = (rv[6] >> 16) | (rv[7] & 0xffff0000u); }
                *(LAS v4u*)(Lp + HG_KMT + (2 * cp + e) * HG_TS + quarter * 16) = kk;
                *(LAS v4u*)(Lp + HG_VT + (2 * cp + e) * HG_TS + quarter * 16) = vv;
            }
            if (quarter == 0) { *(LAS float*)(Lp + HG_C + (2 * cp) * 4) = tot[0]; *(LAS float*)(Lp + HG_C + (2 * cp + 1) * 4) = tot[1]; }
            if (quarter == 3) { *(LAS float*)(Lp + HG_C + 512 + (2 * cp) * 4) = tot[0]; *(LAS float*)(Lp + HG_C + 512 + (2 * cp + 1) * 4) = tot[1]; }
        }
        if (R + 1 < SEQ / 64) HG_LOAD_RAW(R + 1);
        __syncthreads();
        {
            LAS unsigned char* La = L + (wv >> 2) * HG_CHUNK; const int tile = wv & 3, ti = tile >> 1, si = tile & 1;
            v2u w2;
            if (tile == 1) { w2.x = 0u; w2.y = 0u; }
            else {
                hf32x4 acc = (hf32x4){0.f, 0.f, 0.f, 0.f};
#pragma unroll
                for (int u = 0; u < 4; ++u) { const bf16x8 a = ld_frag(La + HG_KM + (16 * si + fr) * HG_RS + u * 64 + g * 16), bq = ld_frag(La + HG_QM + (16 * ti + fr) * HG_RS + u * 64 + g * 16);
                    acc = MFMA16(a, bq, acc); }
                const int tt = 16 * ti + fr, s0 = 16 * si + 4 * g;
                const float a0 = (s0 + 0 <= tt) ? acc[0] : 0.f, a1 = (s0 + 1 <= tt) ? acc[1] : 0.f, a2 = (s0 + 2 <= tt) ? acc[2] : 0.f, a3 = (s0 + 3 <= tt) ? acc[3] : 0.f;
                w2.x = pk2(a0, a1); w2.y = pk2(a2, a3);
            }
            *(LAS v2u*)(La + HG_A + (16 * ti + fr) * HG_TS + (16 * si + 4 * g) * 2) = w2;
        }
        __syncthreads();
#pragma unroll
        for (int cpar = 0; cpar < 2; ++cpar) {
            LAS unsigned char* Lc = L + cpar * HG_CHUNK; const int n = 2 * R + cpar;
#pragma unroll
            for (int mt = 0; mt < 8; ++mt) { const hf32x4 cv = *(LAS hf32x4*)(Lc + HG_C + (16 * mt + 4 * g) * 4); T[mt] = T[mt] * cv; }
            bf16x8 Tb[4];
#pragma unroll
            for (int u = 0; u < 4; ++u) { v4u t4; t4.x = pk2(T[2 * u][0], T[2 * u][1]); t4.y = pk2(T[2 * u][2], T[2 * u][3]); t4.z = pk2(T[2 * u + 1][0], T[2 * u + 1][1]); t4.w = pk2(T[2 * u + 1][2], T[2 * u + 1][3]);
                Tb[u] = __builtin_bit_cast(bf16x8, t4); }
            const bf16x8 vfrag = ld_frag(Lc + HG_VT + (16 * wv + fr) * HG_TS + g * 16);
            hf32x4 o[2];
#pragma unroll
            for (int ti = 0; ti < 2; ++ti) { o[ti] = (hf32x4){0.f, 0.f, 0.f, 0.f};
#pragma unroll
                for (int u = 0; u < 4; ++u) { const bf16x8 a = ld_frag(Lc + HG_QM + (16 * ti + fr) * HG_RS + u * 64 + g * 16); o[ti] = MFMA16(a, Tb[u], o[ti]); }
                const bf16x8 aa = ld_frag(Lc + HG_A + (16 * ti + fr) * HG_TS + g * 16); o[ti] = MFMA16(aa, vfrag, o[ti]); }
#pragma unroll
            for (int ti = 0; ti < 2; ++ti)
#pragma unroll
                for (int r = 0; r < 4; ++r) { const int p_ = 32 * n + 16 * ti + 4 * g + r; const int tok_ = dir ? (SEQ - 1 - p_) : p_; Ob[(size_t)tok_ * 1024 + h * 128 + 16 * wv + fr] = o[ti][r]; }
#pragma unroll
            for (int mt = 0; mt < 8; ++mt) { const bf16x8 a = ld_frag(Lc + HG_KMT + (16 * mt + fr) * HG_TS + g * 16); T[mt] = MFMA16(a, vfrag, T[mt]); }
#pragma unroll
            for (int mt = 0; mt < 8; ++mt) { const hf32x4 cv = *(LAS hf32x4*)(Lc + HG_C + 512 + (16 * mt + 4 * g) * 4); T[mt] = T[mt] * cv; }
        }
        __syncthreads();
    }
#undef HG_LOAD_RAW
}
__device__ __forceinline__ void hgrn_finalize(Ctx& F, int l, int bh) {
    const int b = bh >> 3, h = bh & 7, lane = F.lane, tq = lane >> 4, cl = lane & 15;
    const float* Of = F.obuf() + (size_t)b * SEQ * 1024; const float* Obw = hg_obw(F, b);
    const f32x4 ng0 = *(const f32x4*)(F.hg_norm_g() + l * 128 + 8 * cl), ng1 = *(const f32x4*)(F.hg_norm_g() + l * 128 + 8 * cl + 4);
    for (int t4 = F.wave; t4 < SEQ / 4; t4 += 8) {
        const int tok = 4 * t4 + tq; const size_t off = (size_t)tok * 1024 + h * 128 + 8 * cl;
        f32x4 a0 = *(const f32x4*)(Of + off), a1 = *(const f32x4*)(Of + off + 4); const f32x4 b0 = *(const f32x4*)(Obw + off), b1 = *(const f32x4*)(Obw + off + 4);
        a0 = a0 + b0; a1 = a1 + b1;
        float ss = (a0.x * a0.x + a0.y * a0.y) + (a0.z * a0.z + a0.w * a0.w) + (a1.x * a1.x + a1.y * a1.y) + (a1.z * a1.z + a1.w * a1.w);
        ss += __shfl_xor(ss, 1); ss += __shfl_xor(ss, 2); ss += __shfl_xor(ss, 4); ss += __shfl_xor(ss, 8);
        const float rs = 1.f / sqrtf(ss * (1.f / 128.f) + RMS_EPS);
        const v4u gq = *(const v4u*)(F.P() + ((size_t)b * SEQ + tok) * INC + C_GH + h * 128 + 8 * cl);
        float gv[8];
#pragma unroll
        for (int w = 0; w < 4; ++w) { gv[2 * w] = __uint_as_float(gq[w] << 16); gv[2 * w + 1] = __uint_as_float(gq[w] & 0xffff0000u); }
        float y[8];
        y[0] = a0.x * rs * ng0.x; y[1] = a0.y * rs * ng0.y; y[2] = a0.z * rs * ng0.z; y[3] = a0.w * rs * ng0.w;
        y[4] = a1.x * rs * ng1.x; y[5] = a1.y * rs * ng1.y; y[6] = a1.z * rs * ng1.z; y[7] = a1.w * rs * ng1.w;
#pragma unroll
        for (int w = 0; w < 8; ++w) y[w] *= gv[w] * sigmoidf_(gv[w]);
        v4u o; o.x = pk2(y[0], y[1]); o.y = pk2(y[2], y[3]); o.z = pk2(y[4], y[5]); o.w = pk2(y[6], y[7]);
        *(v4u*)(F.Y() + ((size_t)b * SEQ + tok) * MIXW + h * 128 + 8 * cl) = o;
    }
}

typedef short s16x4 __attribute__((ext_vector_type(4)));
constexpr int NA_K = 0, NA_V = 65536, NA_X = 131072, NA_RPB = NA_X + 4 * 64 * 18 * 4;
static_assert(NA_RPB + 465 * 4 <= LDS_FLAG, "NA LDS map");
constexpr float LOG2E = 1.4426950408889634f;
__device__ __forceinline__ void na_unit(Ctx& F, int l, int bh) {
    const int b = bh >> 4, h = bh & 15, lane = F.lane, wv = F.wave, tid = F.tid;
    const int j = wv & 3, kh = wv >> 2, fr = lane & 15, g = lane >> 4;
    LAS unsigned char* L = F.lds;
    const bf16* Pb = F.P() + (size_t)b * SEQ * INC;
    const int ks = (j == 0) ? 0 : (j == 1) ? 8 : (j == 2) ? 24 : 32;
    const int qcol = 16 * j + fr, cs = min(max(qcol - 8, 0), 48);
    LAS float* rpbl = (LAS float*)(L + NA_RPB);
    for (int i = tid; i < 465; i += 512) rpbl[i] = F.rpb()[((size_t)l * 16 + h) * 465 + i] * LOG2E;
    const int tokc = tid >> 3, chunk = tid & 7;
    const int kst = tokc * 128 + ((chunk ^ (tokc & 7)) << 4), vst = tokc * 128 + ((chunk ^ (((tokc >> 1) & 3) << 1)) << 4);
    const bf16* kvsrc = Pb + (size_t)tokc * INC + h * 64 + chunk * 8;
#pragma unroll 2
    for (int R = 0; R < 8; ++R) { const v4u kk = *(const v4u*)(kvsrc + (size_t)R * 64 * INC + C_KN), vv = *(const v4u*)(kvsrc + (size_t)R * 64 * INC + C_VN);
        *(LAS v4u*)(L + NA_K + R * 8192 + kst) = kk; *(LAS v4u*)(L + NA_V + R * 8192 + vst) = vv; }
    bf16x8 qf[2];
    { const bf16* qp_ = Pb + (size_t)(0 * 64 + qcol) * INC + C_QN + h * 64 + 8 * g; qf[0] = *(const bf16x8*)qp_; qf[1] = *(const bf16x8*)(qp_ + 32); }
    __syncthreads();
    float bias[4][2][4];
    int koff[2], voff[2];
#pragma unroll
    for (int ct = 0; ct < 2; ++ct) { const int col = ks + 16 * ct + fr; koff[ct] = col * 128 + ((g ^ (col & 7)) << 4);
        const int vcol = ks + 16 * ct + 4 * g + ((lane & 15) >> 2), p_ = lane & 3; voff[ct] = vcol * 128 + (((p_ >> 1) ^ (((vcol >> 1) & 3) << 1)) << 4) + (p_ & 1) * 8; }
    for (int r = 0; r < 32; ++r) {
        const int rs = min(max(r - 4, 0), 24);
        if (r <= 4 || r >= 29) { const int delta = rs - r + 7;
#pragma unroll
            for (int i = 0; i < 4; ++i)
#pragma unroll
                for (int ct = 0; ct < 2; ++ct)
#pragma unroll
                    for (int e = 0; e < 4; ++e) { const int kc = ks + 16 * ct + 4 * g + e; const bool inw = (kc >= cs) && (kc < cs + 16);
                        const int idx = (4 * kh + i + delta) * 31 + (kc - qcol + 15);
                        bias[i][ct][e] = inw ? rpbl[inw ? idx : 0] : -1e30f; } }
        const bool do_stage = (r >= 4) && (r <= 27);
        v4u kreg, vreg; bf16x8 qn[2];
        if (do_stage) { const size_t ro = (size_t)(r + 4) * 64 * INC; kreg = *(const v4u*)(kvsrc + ro + C_KN); vreg = *(const v4u*)(kvsrc + ro + C_VN); }
        if (r + 1 < 32) { const bf16* qp_ = Pb + (size_t)((r + 1) * 64 + qcol) * INC + C_QN + h * 64 + 8 * g; qn[0] = *(const bf16x8*)qp_; qn[1] = *(const bf16x8*)(qp_ + 32); }
        const size_t tokq = (size_t)b * SEQ + r * 64 + qcol;
        v2u gate[4];
        if (kh == 0) {
#pragma unroll
            for (int mt = 0; mt < 4; ++mt) gate[mt] = *(const v2u*)(F.P() + tokq * INC + C_GN + h * 64 + 16 * mt + 4 * g); }
        hf32x4 sacc[4][2];
#pragma unroll
        for (int i = 0; i < 4; ++i) { const int slot = (rs + 4 * kh + i) & 7;
#pragma unroll
            for (int ct = 0; ct < 2; ++ct) { hf32x4 a = (hf32x4){0.f, 0.f, 0.f, 0.f};
#pragma unroll
                for (int u = 0; u < 2; ++u) { const bf16x8 kf = ld_frag(L + NA_K + slot * 8192 + (koff[ct] ^ (u << 6))); a = MFMA16(kf, qf[u], a); }
                sacc[i][ct] = a; } }
        float mx = -3e38f;
#pragma unroll
        for (int i = 0; i < 4; ++i)
#pragma unroll
            for (int ct = 0; ct < 2; ++ct)
#pragma unroll
                for (int e = 0; e < 4; ++e) { const float sv = sacc[i][ct][e] * (0.125f * LOG2E) + bias[i][ct][e]; sacc[i][ct][e] = sv; mx = fmaxf(mx, sv); }
        mx = fmaxf(mx, __shfl_xor(mx, 16)); mx = fmaxf(mx, __shfl_xor(mx, 32));
        float ls = 0.f; bf16x8 pf[4];
#pragma unroll
        for (int i = 0; i < 4; ++i) { float p[8];
#pragma unroll
            for (int ct = 0; ct < 2; ++ct)
#pragma unroll
                for (int e = 0; e < 4; ++e) { p[4 * ct + e] = __builtin_amdgcn_exp2f(sacc[i][ct][e] - mx); ls += p[4 * ct + e]; }
            v4u w; w.x = pk2(p[0], p[1]); w.y = pk2(p[2], p[3]); w.z = pk2(p[4], p[5]); w.w = pk2(p[6], p[7]); pf[i] = __builtin_bit_cast(bf16x8, w); }
        ls += __shfl_xor(ls, 16); ls += __shfl_xor(ls, 32);
        hf32x4 oacc[4];
#pragma unroll
        for (int mt = 0; mt < 4; ++mt) oacc[mt] = (hf32x4){0.f, 0.f, 0.f, 0.f};
#pragma unroll
        for (int i = 0; i < 4; ++i) { const int slot = (rs + 4 * kh + i) & 7;
#pragma unroll
            for (int mt = 0; mt < 4; ++mt) {
                const s16x4 v0 = __builtin_amdgcn_ds_read_tr16_b64_v4i16((LAS s16x4*)(L + NA_V + slot * 8192 + (voff[0] ^ (mt << 5))));
                const s16x4 v1 = __builtin_amdgcn_ds_read_tr16_b64_v4i16((LAS s16x4*)(L + NA_V + slot * 8192 + (voff[1] ^ (mt << 5))));
                const bf16x8 vf = __builtin_shufflevector(v0, v1, 0, 1, 2, 3, 4, 5, 6, 7);
                oacc[mt] = MFMA16(vf, pf[i], oacc[mt]); } }
        LAS float* X = (LAS float*)(L + NA_X) + (j * 64 + lane) * 18;
        if (kh == 1) {
#pragma unroll
            for (int mt = 0; mt < 4; ++mt) { X[4 * mt + 0] = oacc[mt][0]; X[4 * mt + 1] = oacc[mt][1]; X[4 * mt + 2] = oacc[mt][2]; X[4 * mt + 3] = oacc[mt][3]; }
            X[16] = mx; X[17] = ls;
        }
        __syncthreads();
        if (do_stage) { const int slot = (r + 4) & 7; *(LAS v4u*)(L + NA_K + slot * 8192 + kst) = kreg; *(LAS v4u*)(L + NA_V + slot * 8192 + vst) = vreg; }
        if (kh == 0) {
            const float m1 = X[16], l1 = X[17]; const float mm = fmaxf(mx, m1);
            const float a0 = __builtin_amdgcn_exp2f(mx - mm), a1 = __builtin_amdgcn_exp2f(m1 - mm);
            const float inv = 1.f / (a0 * ls + a1 * l1);
            const float c0 = a0 * inv, c1 = a1 * inv;
#pragma unroll
            for (int mt = 0; mt < 4; ++mt) {
                float o[4];
#pragma unroll
                for (int e = 0; e < 4; ++e) o[e] = c0 * oacc[mt][e] + c1 * X[4 * mt + e];
                const float g0 = __uint_as_float(gate[mt].x << 16), g1 = __uint_as_float(gate[mt].x & 0xffff0000u), g2 = __uint_as_float(gate[mt].y << 16), g3 = __uint_as_float(gate[mt].y & 0xffff0000u);
                o[0] *= g0 * sigmoidf_(g0); o[1] *= g1 * sigmoidf_(g1); o[2] *= g2 * sigmoidf_(g2); o[3] *= g3 * sigmoidf_(g3);
                v2u w; w.x = pk2(o[0], o[1]); w.y = pk2(o[2], o[3]);
                *(v2u*)(F.Y() + tokq * MIXW + 1024 + h * 64 + 16 * mt + 4 * g) = w; }
        }
        if (r + 1 < 32) { qf[0] = qn[0]; qf[1] = qn[1]; }
        __syncthreads();
    }
}
__device__ __forceinline__ void phase_mix(Ctx& F, int l) {
    unsigned* ctl = (unsigned*)(F.wsp() + WS_CTL);
    volatile LAS unsigned* flag = (volatile LAS unsigned*)(F.lds + LDS_FLAG);
    for (int w = blockIdx.x; w < 256; w += gridDim.x) {
        if (w < 128) {
            const int u = w;
            hgrn_unit(F, l, u);
            asm volatile("s_waitcnt vmcnt(0)" ::: "memory");
            __syncthreads();
            if (F.tid == 0) {
                __builtin_amdgcn_fence(__ATOMIC_RELEASE, "agent");
                asm volatile("s_waitcnt vmcnt(0)" ::: "memory");
                const unsigned old = __hip_atomic_fetch_add(ctl + CW_HG + (l * 64 + (u >> 1)) * 64, 1u, __ATOMIC_RELAXED, __HIP_MEMORY_SCOPE_AGENT);
                if (old == 1u) { __builtin_amdgcn_fence(__ATOMIC_ACQUIRE, "agent"); asm volatile("s_waitcnt vmcnt(0)" ::: "memory"); }
                flag[0] = old;
            }
            __syncthreads();
            const bool last = flag[0] == 1u;
            __syncthreads();
            if (last) hgrn_finalize(F, l, u >> 1);
        } else {
            na_unit(F, l, w - 128);
        }
        __syncthreads();
    }
}

__global__ void __launch_bounds__(512, 2) fwd_kernel(Args a) {
    extern __shared__ __attribute__((aligned(16))) unsigned char lds[];
    Ctx F;
    F.lds = (LAS unsigned char*)lds; F.tid = threadIdx.x; F.lane = F.tid & 63; F.wave = __builtin_amdgcn_readfirstlane(F.tid >> 6);
    F.a = &a;
    for (int ph = a.ph_lo; ph < a.ph_hi; ++ph) {
        { int t_ = threadIdx.x; asm volatile("" : "+v"(t_)); F.tid = t_; F.lane = t_ & 63; F.wave = __builtin_amdgcn_readfirstlane(t_ >> 6); }
        if (ph == 0) phase_prologue(F);
        else if (ph == 1) phase_ln0(F);
        else {
            const int l = (ph - 2) >> 2, k = (ph - 2) & 3;
            if (k == 0) {
                pg8::Gemm g{F.H(), F.wt_in() + (size_t)l * INC * DM, MTOK, INC, DM}; pg8::StaticOrder S; S.init(MTOK, INC, gridDim.x, (int)blockIdx.x);
                pg8::EpiBf16<0> E{F.P(), INC, nullptr, 0, 0, 1.f};
                pg8::gemm_phase<pg8::EpiBf16<0>, pg8::StaticOrder, true, true>(F.lds, g, S, E);
            } else if (k == 1) {
                phase_mix(F, l);
            } else if (k == 2) {
                pg8::Gemm g{F.Y(), F.wt_out() + (size_t)l * DM * MIXW, MTOK, DM, MIXW}; pg8::StaticOrder S; S.init(MTOK, DM, gridDim.x, (int)blockIdx.x);
                EpiZ E{l == 0 ? F.x() : F.out(), F.out(), F.mod() + (size_t)l * NB * ADAC + 2 * DM};
                pg8::gemm_phase<EpiZ, pg8::StaticOrder, false, true>(F.lds, g, S, E);
            } else {
                phase_ln(F, l);
            }
        }
        if (ph + 1 < a.ph_hi) { __syncthreads(); cg::this_grid().sync(); }
    }
}

__global__ void fill_kernel(float* o, int n, float v) { for (int i = blockIdx.x * blockDim.x + threadIdx.x; i < n; i += gridDim.x * blockDim.x) o[i] = v; }

extern "C" void kernel_launch(void* const* d_in, const int* in_sizes, int n_in, void* d_out, int out_size, void* d_ws, size_t ws_size, hipStream_t stream) {
    static int grid = 0;
    if (grid == 0) {
        int dev = 0, cus = 0;
        if (hipGetDevice(&dev) != hipSuccess || hipDeviceGetAttribute(&cus, hipDeviceAttributeMultiprocessorCount, dev) != hipSuccess) { grid = -1; return; }
        if (hipFuncSetAttribute((const void*)fwd_kernel, hipFuncAttributeMaxDynamicSharedMemorySize, LDS_BYTES) != hipSuccess) { grid = -1; return; }
        int per_cu = 0;
        if (hipOccupancyMaxActiveBlocksPerMultiprocessor(&per_cu, (const void*)fwd_kernel, 512, LDS_BYTES) != hipSuccess || per_cu < 1) { fprintf(stderr, "occupancy query: %d\n", per_cu); }
        (void)hipGetLastError();
        grid = cus * (per_cu < 1 ? 1 : (per_cu > 1 ? 1 : per_cu));
    }
    if (grid < 0) return;
    if (n_in != 11 || out_size != MTOK * DM || ws_size < WS_END) { fill_kernel<<<256, 256, 0, stream>>>((float*)d_out, out_size, ws_size < WS_END ? 12345.0f : 54321.0f); return; }
    Args a{};
    for (int i = 0; i < 11; ++i) a.in[i] = (const float*)d_in[i];
    a.out = (float*)d_out; a.ws = (unsigned char*)d_ws;
    a.ph_lo = 0; a.ph_hi = NPHASE; a.coop = 1;
    void* kargs[] = {&a};
    hipError_t e = hipLaunchCooperativeKernel((const void*)fwd_kernel, dim3(grid), dim3(512), kargs, LDS_BYTES, stream);
    if (e != hipSuccess) fprintf(stderr, "cooperative launch failed: %s (grid %d)\n", hipGetErrorString(e), grid);
}
```

```cpp
#include <hip/hip_runtime.h>
#include <hip/hip_cooperative_groups.h>
#include <cstdio>
#include <cstdint>
namespace pg8 {
#define PG8_LAS __attribute__((address_space(3)))
typedef unsigned short bf16_t;
typedef short bf16x8 __attribute__((ext_vector_type(8)));
typedef float f32x4 __attribute__((ext_vector_type(4)));
typedef unsigned u32x4 __attribute__((ext_vector_type(4)));
constexpr int BM = 256, BK = 64, HALF = 128, HTB = HALF * BK * 2  , STAGE_BYTES = 8 * HTB, NXCD = 8, WGM = 8;

__host__ __device__ __forceinline__ int lds_byte(int r, int c) { const int st = (r >> 4) * 2 + (c >> 5), rr = r & 15, cc = c & 31, ob = rr * 64 + cc * 2; return st * 1024 + (ob ^ (((ob >> 9) & 1) << 5)); }
__host__ __device__ __forceinline__ void stage_rc(int b, int& R, int& C) { const int st = b / 1024, sb = b % 1024, swz = sb ^ (((sb >> 9) & 1) << 5); R = (st >> 1) * 16 + swz / 64; C = (st & 1) * 32 + (swz % 64) / 2; }
__host__ __device__ __forceinline__ int perm32(int rho) { const int n = rho >> 4, i = rho & 15; return 8 * (i >> 2) + 4 * n + (i & 3); }

struct Unit { int pm, pn; };
struct Gemm { const bf16_t* A; const bf16_t* Bt; int M, N, K; };

struct StaticOrder {
    int nM, nN, nwg, G, c;
    __host__ __device__ void init(int M, int N, int G_, int c_) { nM = M / BM; nN = N / BM; nwg = nM * nN; G = G_; c = c_; }
    __host__ __device__ bool next(int i, Unit& u) const {
        const long L = (long)i * G + c; if (L >= nwg) return false;
        int wgid = (int)L; { const int q = nwg / NXCD, r = nwg % NXCD, xcd = wgid % NXCD, off = wgid / NXCD; wgid = (xcd < r ? xcd * (q + 1) : r * (q + 1) + (xcd - r) * q) + off; }
        const int nig = WGM * nN, gid = wgid / nig, fm = gid * WGM, gsz = (nM - fm) < WGM ? (nM - fm) : WGM;
        u.pm = fm + ((wgid % nig) % gsz); u.pn = (wgid % nig) / gsz; return true;
    }
    __device__ __forceinline__ void a_ready(const Unit&) const {}
    __device__ __forceinline__ void done(const Unit&) const {}
};

__device__ __forceinline__ unsigned cvt_pk_bf16(float lo, float hi) { unsigned r; asm volatile("v_cvt_pk_bf16_f32 %0, %1, %2" : "=v"(r) : "v"(lo), "v"(hi)); return r; }
typedef float f32x2 __attribute__((ext_vector_type(2)));
__device__ __forceinline__ f32x2 gelu_pk(f32x2 v) {
    const f32x2 av = __builtin_elementwise_abs(v), d = av * 0.2316418882f + 1.0f;
    f32x2 t; t.x = __builtin_amdgcn_rcpf(d.x); t.y = __builtin_amdgcn_rcpf(d.y);
    f32x2 q = t * 0.5307027145f + (-0.7265760135f); q = q * t + 0.7107068705f; q = q * t + (-0.142248368f); q = q * t + 0.127414796f; q = q * t;
    const f32x2 s = (v * v) * (-0.72134752044f);
    f32x2 e; e.x = __builtin_amdgcn_exp2f(s.x); e.y = __builtin_amdgcn_exp2f(s.y);
    const f32x2 m = v * (q * e), r = v - m;
    f32x2 o; o.x = v.x < 0.f ? m.x : r.x; o.y = v.y < 0.f ? m.y : r.y; return o;
}

template <int ACT  > struct EpiBf16 {
    static constexpr bool PERM = true, AFTER_DRAIN = false; static_assert(ACT == 0 || ACT == 1, "EpiBf16: ACT is 0 (none) or 1 (gelu_pk)");
    bf16_t* O; int ldc; const float* bias; int split_cols; size_t split_stride; float scale0;
    __device__ __forceinline__ void operator()(const f32x4 (&acc)[2][2][4][2], const Unit& u, int wr, int wc, int fr, int fq) const {
        const int row0 = u.pm * BM + wr * 64 + fr; int colt = u.pn * BM; bf16_t* base = O;
        float sc = 1.f; if (split_cols) { const int t = colt / split_cols; base += (size_t)t * split_stride; colt -= t * split_cols; if (t == 0) sc = scale0; }
        const int col0 = colt + wc * 32 + 8 * fq, bcol0 = u.pn * BM + wc * 32 + 8 * fq;
        f32x4 bv[2][2];
#pragma unroll
        for (int bj = 0; bj < 2; ++bj)
#pragma unroll
            for (int n = 0; n < 2; ++n) bv[bj][n] = bias ? *(const f32x4*)(bias + bcol0 + bj * HALF + 4 * n) : (f32x4){0.f, 0.f, 0.f, 0.f};
#pragma unroll
        for (int ai = 0; ai < 2; ++ai)
#pragma unroll
            for (int m = 0; m < 4; ++m) { bf16_t* rowp = base + (size_t)(row0 + ai * HALF + m * 16) * ldc + col0;
#pragma unroll
                for (int bj = 0; bj < 2; ++bj) { f32x4 v0 = acc[ai][bj][m][0] + bv[bj][0], v1 = acc[ai][bj][m][1] + bv[bj][1];
                    if (ACT == 1) { f32x2 a = gelu_pk((f32x2){v0[0], v0[1]}), b = gelu_pk((f32x2){v0[2], v0[3]}), c = gelu_pk((f32x2){v1[0], v1[1]}), d = gelu_pk((f32x2){v1[2], v1[3]});
                        v0 = (f32x4){a.x, a.y, b.x, b.y}; v1 = (f32x4){c.x, c.y, d.x, d.y}; }
                    v0 = v0 * sc; v1 = v1 * sc; u32x4 w; w.x = cvt_pk_bf16(v0[0], v0[1]); w.y = cvt_pk_bf16(v0[2], v0[3]); w.z = cvt_pk_bf16(v1[0], v1[1]); w.w = cvt_pk_bf16(v1[2], v1[3]);
                    *(u32x4*)(rowp + bj * HALF) = w; } }
    }
};

struct PanelStats {
    unsigned* xbuf;
    unsigned* cnt;
    unsigned* tmo;
    int ntn; float eps;
    unsigned code;
    __device__ __forceinline__ bool run(const f32x4 (&v)[2][2][4][2], const Unit& u, int wr, int wc, int fr, int fq, PG8_LAS unsigned char* lds, int wid, int lane) const {
        typedef float f32x2v __attribute__((ext_vector_type(2)));
        PG8_LAS f32x2v* P = (PG8_LAS f32x2v*)lds;
        PG8_LAS f32x2v* S = (PG8_LAS f32x2v*)(lds + 8192);
        PG8_LAS unsigned* flag = (PG8_LAS unsigned*)(lds + 8192 + 2048);
#pragma unroll
        for (int ai = 0; ai < 2; ++ai)
#pragma unroll
            for (int m = 0; m < 4; ++m) {
                float s = 0.f;
#pragma unroll
                for (int bj = 0; bj < 2; ++bj)
#pragma unroll
                    for (int n = 0; n < 2; ++n) { const f32x4 x = v[ai][bj][m][n]; s += (x[0] + x[1]) + (x[2] + x[3]); }
                s += __shfl_xor(s, 16); s += __shfl_xor(s, 32);
                const float mw = s * (1.0f / 64.0f); float q = 0.f;
#pragma unroll
                for (int bj = 0; bj < 2; ++bj)
#pragma unroll
                    for (int n = 0; n < 2; ++n) { const f32x4 d = v[ai][bj][m][n] - mw; q += (d[0] * d[0] + d[1] * d[1]) + (d[2] * d[2] + d[3] * d[3]); }
                q += __shfl_xor(q, 16); q += __shfl_xor(q, 32);
                if (fq == 0) P[(ai * HALF + wr * 64 + m * 16 + fr) * 4 + wc] = (f32x2v){mw, q};
            }
        asm volatile("s_waitcnt lgkmcnt(0)" ::: "memory"); __builtin_amdgcn_s_barrier(); asm volatile("" ::: "memory");
#if defined(BROKEN_EXCHANGE_NO_WAIT)
#warning BROKEN CONTROL BUILD: the row-statistics exchange does not wait; results are wrong by design
        if (blockIdx.x >= 64) { const long long t0_ = clock64(); while (clock64() - t0_ < 60000) __builtin_amdgcn_s_sleep(8); }
#endif
        const int row = wid * 32 + (lane & 31);
        if (lane < 32) {
            const f32x2v a = P[row * 4 + 0], b = P[row * 4 + 1], c = P[row * 4 + 2], d = P[row * 4 + 3];
            const float mt = (a.x + b.x + c.x + d.x) * 0.25f;
            const float da = a.x - mt, db = b.x - mt, dc = c.x - mt, dd = d.x - mt;
            const float m2 = (a.y + b.y) + (c.y + d.y) + 64.0f * ((da * da + db * db) + (dc * dc + dd * dd));
            unsigned long long* slot = (unsigned long long*)xbuf + ((size_t)(u.pm * BM + row) * 4 + u.pn);
            __hip_atomic_store(slot, ((unsigned long long)__float_as_uint(m2) << 32) | __float_as_uint(mt), __ATOMIC_RELAXED, __HIP_MEMORY_SCOPE_AGENT);
        }
        asm volatile("s_waitcnt vmcnt(0)" ::: "memory");
        if (lane == 0) __hip_atomic_fetch_add(cnt + 64 * u.pm, 1u, __ATOMIC_RELAXED, __HIP_MEMORY_SCOPE_AGENT);
        if (wid == 0) {
            bool dead = false; const unsigned long long t0 = __builtin_amdgcn_s_memrealtime(); const unsigned want = 8u * (unsigned)ntn;
            for (;;) {
#if defined(BROKEN_EXCHANGE_NO_WAIT)
                break;
#endif
                if ((unsigned)__builtin_amdgcn_readfirstlane(__hip_atomic_load(cnt + 64 * u.pm, __ATOMIC_RELAXED, __HIP_MEMORY_SCOPE_AGENT)) >= want) break;
                if (__builtin_amdgcn_s_memrealtime() - t0 > 2000000ull) {
                    if (lane == 0) { unsigned expect = 0u; __hip_atomic_compare_exchange_strong(tmo + 1, &expect, code | (unsigned)(u.pm & 0xff), __ATOMIC_RELAXED, __ATOMIC_RELAXED, __HIP_MEMORY_SCOPE_AGENT);
                                     __hip_atomic_store(tmo, 1u, __ATOMIC_RELAXED, __HIP_MEMORY_SCOPE_AGENT); }
                    dead = true; break; }
                __builtin_amdgcn_s_sleep(2);
            }
            __builtin_amdgcn_fence(__ATOMIC_ACQUIRE, "agent");
            if (lane == 0) flag[0] = dead ? 1u : 0u;
        }
        asm volatile("s_waitcnt vmcnt(0) lgkmcnt(0)" ::: "memory"); __builtin_amdgcn_s_barrier(); asm volatile("" ::: "memory");
        const bool bad = flag[0] != 0u;
        if (lane < 32) {
            const unsigned long long* slot = (const unsigned long long*)xbuf + (size_t)(u.pm * BM + row) * 4; float mt[4], m2[4]; float ms = 0.f;
#pragma unroll
            for (int t = 0; t < 4; ++t) { if (t < ntn) { const unsigned long long w = __hip_atomic_load(slot + t, __ATOMIC_RELAXED, __HIP_MEMORY_SCOPE_AGENT); mt[t] = __uint_as_float((unsigned)w); m2[t] = __uint_as_float((unsigned)(w >> 32)); } else { mt[t] = 0.f; m2[t] = 0.f; } ms += mt[t]; }
            const float mean = ms / (float)ntn; float q = 0.f;
#pragma unroll
            for (int t = 0; t < 4; ++t) if (t < ntn) { const float dm = mt[t] - mean; q += m2[t] + 256.0f * dm * dm; }
            S[row] = (f32x2v){mean, 1.0f / sqrtf(q / (256.0f * (float)ntn) + eps)};
        }
        asm volatile("s_waitcnt lgkmcnt(0)" ::: "memory"); __builtin_amdgcn_s_barrier(); asm volatile("" ::: "memory");
        return bad;
    }
};
struct EpiLnRes {
    static constexpr bool PERM = false, AFTER_DRAIN = true;
    const float* base; float* out; int ldc; const float* bias; PanelStats st; unsigned poison;
    __device__ __forceinline__ void fused(f32x4 (&acc)[2][2][4][2], const Unit& u, int wr, int wc, int fr, int fq, PG8_LAS unsigned char* lds, int wid, int lane) const {
        typedef float f32x2v __attribute__((ext_vector_type(2)));
        const PG8_LAS f32x2v* S = (const PG8_LAS f32x2v*)(lds + 8192);
        const int col0 = u.pn * BM + wc * 32 + 4 * fq;
#pragma unroll
        for (int bj = 0; bj < 2; ++bj)
#pragma unroll
            for (int n = 0; n < 2; ++n) { const f32x4 bv = bias ? *(const f32x4*)(bias + col0 + bj * HALF + n * 16) : (f32x4){0.f, 0.f, 0.f, 0.f};
#pragma unroll
                for (int ai = 0; ai < 2; ++ai)
#pragma unroll
                    for (int m = 0; m < 4; ++m) acc[ai][bj][m][n] += bv; }
        f32x4 pre[4][2][2];
#pragma unroll
        for (int m = 0; m < 4; ++m) { const size_t off = (size_t)(u.pm * BM + wr * 64 + m * 16 + fr) * ldc + col0;
#pragma unroll
            for (int bj = 0; bj < 2; ++bj)
#pragma unroll
                for (int n = 0; n < 2; ++n) pre[m][bj][n] = *(const f32x4*)(base + off + bj * HALF + n * 16); }
        const bool bad = st.run(acc, u, wr, wc, fr, fq, lds, wid, lane) || poison != 0u;
        const float qnan = __builtin_nanf("");
#pragma unroll
        for (int ai = 0; ai < 2; ++ai)
#pragma unroll
            for (int m = 0; m < 4; ++m) { const int r = ai * HALF + wr * 64 + m * 16 + fr; const f32x2v sr = S[r]; const size_t off = (size_t)(u.pm * BM + r) * ldc + col0;
#pragma unroll
                for (int bj = 0; bj < 2; ++bj)
#pragma unroll
                    for (int n = 0; n < 2; ++n) { const f32x4 bs = ai == 0 ? pre[m][bj][n] : *(const f32x4*)(base + off + bj * HALF + n * 16); f32x4 o = bs + (acc[ai][bj][m][n] - sr.x) * sr.y;
                        if (bad) o = (f32x4){qnan, qnan, qnan, qnan}; *(f32x4*)(out + off + bj * HALF + n * 16) = o; }
                if (m & 1) asm volatile("" ::: "memory"); }
    }
};
struct EpiLnResLn {
    static constexpr bool PERM = false, AFTER_DRAIN = true;
    const float* base; float* out; bf16_t* xn; int ldc; const float* bias; PanelStats st1, st2; unsigned poison;
    __device__ __forceinline__ void fused(f32x4 (&acc)[2][2][4][2], const Unit& u, int wr, int wc, int fr, int fq, PG8_LAS unsigned char* lds, int wid, int lane) const {
        typedef float f32x2v __attribute__((ext_vector_type(2))); typedef unsigned u32x2v __attribute__((ext_vector_type(2)));
        const PG8_LAS f32x2v* S = (const PG8_LAS f32x2v*)(lds + 8192);
        const int col0 = u.pn * BM + wc * 32 + 4 * fq;
#pragma unroll
        for (int bj = 0; bj < 2; ++bj)
#pragma unroll
            for (int n = 0; n < 2; ++n) { const f32x4 bv = bias ? *(const f32x4*)(bias + col0 + bj * HALF + n * 16) : (f32x4){0.f, 0.f, 0.f, 0.f};
#pragma unroll
                for (int ai = 0; ai < 2; ++ai)
#pragma unroll
                    for (int m = 0; m < 4; ++m) acc[ai][bj][m][n] += bv; }
        bool bad = st1.run(acc, u, wr, wc, fr, fq, lds, wid, lane) || poison != 0u;
        const float qnan = __builtin_nanf("");
#pragma unroll
        for (int ai = 0; ai < 2; ++ai)
#pragma unroll
            for (int m = 0; m < 4; ++m) { const int r = ai * HALF + wr * 64 + m * 16 + fr; const f32x2v sr = S[r]; const size_t off = (size_t)(u.pm * BM + r) * ldc + col0;
#pragma unroll
                for (int bj = 0; bj < 2; ++bj)
#pragma unroll
                    for (int n = 0; n < 2; ++n) { const f32x4 bs = *(const f32x4*)(base + off + bj * HALF + n * 16); acc[ai][bj][m][n] = bs + (acc[ai][bj][m][n] - sr.x) * sr.y; }
                asm volatile("" : "+v"(acc[ai][0][m][0]), "+v"(acc[ai][0][m][1]), "+v"(acc[ai][1][m][0]), "+v"(acc[ai][1][m][1]));
                if (m & 1) asm volatile("" ::: "memory"); }
        const bool bad1 = bad;
        bad = st2.run(acc, u, wr, wc, fr, fq, lds, wid, lane) || bad;
#pragma unroll
        for (int ai = 0; ai < 2; ++ai)
#pragma unroll
            for (int m = 0; m < 4; ++m) { const int r = ai * HALF + wr * 64 + m * 16 + fr; const f32x2v sr = S[r]; const size_t off = (size_t)(u.pm * BM + r) * ldc + col0;
#pragma unroll
                for (int bj = 0; bj < 2; ++bj)
#pragma unroll
                    for (int n = 0; n < 2; ++n) { const f32x4 x1 = acc[ai][bj][m][n]; *(f32x4*)(out + off + bj * HALF + n * 16) = bad1 ? (f32x4){qnan, qnan, qnan, qnan} : x1;
                        const f32x4 o = (x1 - sr.x) * sr.y; u32x2v w; w.x = cvt_pk_bf16(o[0], o[1]); w.y = cvt_pk_bf16(o[2], o[3]);
                        if (bad) { w.x = 0x7fc07fc0u; w.y = 0x7fc07fc0u; } *(u32x2v*)(xn + off + bj * HALF + n * 16) = w; }
                asm volatile("" ::: "memory"); }
    }
};

template <class Epi, class Sched, bool ALIGN_EPI = false, bool SP2 = false>
__device__ __forceinline__ void gemm_phase(PG8_LAS unsigned char* lds, const Gemm g, const Sched& S, const Epi& E) {
    int tid_ = threadIdx.x; asm volatile("" : "+v"(tid_)); const int tid = tid_, wid = __builtin_amdgcn_readfirstlane(tid >> 6), lane = tid & 63, wr = wid >> 2, wc = wid & 3, fr = lane & 15, fq = lane >> 4;
    const int K = g.K, nt = K / BK;
    unsigned voffA[2], voffB[2];
#pragma unroll
    for (int i = 0; i < 2; ++i) { int R, C; stage_rc(tid * 16 + i * 8192, R, C); const int Rb = Epi::PERM ? ((R & ~31) + perm32(R & 31)) : R;
        voffA[i] = (unsigned)(R * K + C) * 2u; voffB[i] = (unsigned)(Rb * K + C) * 2u; }
    const size_t kstep = (size_t)(BK * 2);
    const size_t hstep = (size_t)HALF * K * 2;
    const size_t tstep = 2 * hstep;
    const unsigned ldsw = (unsigned)wid * 1024u;
    const int aoff = lds_byte(wr * 64 + fr, fq * 8), boff = lds_byte(wc * 32 + fr, fq * 8);
#define PG8_SA(b, h) (((b) * 2 + (h)) * HTB)
#define PG8_SB(b, h) ((4 + (b) * 2 + (h)) * HTB)
#define PG8_STAGE(bufoff, gbase, voff) do { _Pragma("unroll") for (int _i = 0; _i < 2; ++_i) \
        __builtin_amdgcn_global_load_lds((const unsigned*)((const char*)(gbase) + (voff)[_i]), (PG8_LAS unsigned*)(lds + (bufoff) + ldsw + _i * 8192), 16, 0, 0); } while (0)
#define PG8_LDA(dst, b, h) do { _Pragma("unroll") for (int m = 0; m < 4; ++m) _Pragma("unroll") for (int k = 0; k < 2; ++k) dst[m][k] = *(const PG8_LAS bf16x8*)(lds + PG8_SA(b, h) + aoff + m * 2048 + k * 1024); } while (0)
#define PG8_LDB(dst, b, h) do { _Pragma("unroll") for (int n = 0; n < 2; ++n) _Pragma("unroll") for (int k = 0; k < 2; ++k) dst[n][k] = *(const PG8_LAS bf16x8*)(lds + PG8_SB(b, h) + boff + n * 2048 + k * 1024); } while (0)
#define PG8_MMA(ai, bj, At, Bt) do { __builtin_amdgcn_s_setprio(1); _Pragma("unroll") for (int m = 0; m < 4; ++m) _Pragma("unroll") for (int n = 0; n < 2; ++n) _Pragma("unroll") for (int k = 0; k < 2; ++k) \
        acc[ai][bj][m][n] = __builtin_amdgcn_mfma_f32_16x16x32_bf16(Bt[n][k], At[m][k], acc[ai][bj][m][n], 0, 0, 0); __builtin_amdgcn_s_setprio(0); } while (0)
#define PG8_WAIT_V(n) asm volatile("s_waitcnt vmcnt(" #n ")" ::: "memory")
#define PG8_WAIT_L(n) asm volatile("s_waitcnt lgkmcnt(" #n ")" ::: "memory")
#define PG8_BAR __builtin_amdgcn_s_barrier()
#define PG8_SCHED __builtin_amdgcn_sched_barrier(0)
    Unit cur, nxt; int ui = 0;
    if (!S.next(0, cur)) return;
    f32x4 acc[2][2][4][2];
#pragma unroll
    for (int a = 0; a < 2; ++a)
#pragma unroll
        for (int b = 0; b < 2; ++b)
#pragma unroll
            for (int m = 0; m < 4; ++m)
#pragma unroll
                for (int n = 0; n < 2; ++n) acc[a][b][m][n] = (f32x4){0.f, 0.f, 0.f, 0.f};
    bf16x8 At[4][2], B0[2][2], B1[2][2];
    const char* cA = (const char*)g.A + (size_t)cur.pm * tstep; const char* cB = (const char*)g.Bt + (size_t)cur.pn * tstep;
    S.a_ready(cur);
    if constexpr (SP2) {
        PG8_STAGE(PG8_SB(0, 0), cB, voffB); PG8_STAGE(PG8_SB(0, 1), cB + hstep, voffB); PG8_STAGE(PG8_SA(0, 0), cA, voffA); PG8_STAGE(PG8_SA(0, 1), cA + hstep, voffA);
        if (wr == 1) PG8_BAR;
        PG8_WAIT_V(2); PG8_BAR;
        PG8_STAGE(PG8_SB(1, 0), cB + kstep, voffB); PG8_STAGE(PG8_SA(1, 0), cA + kstep, voffA); PG8_STAGE(PG8_SB(1, 1), cB + hstep + kstep, voffB);
        PG8_WAIT_V(6); PG8_BAR;
    } else {
        PG8_STAGE(PG8_SB(0, 0), cB, voffB); PG8_STAGE(PG8_SA(0, 0), cA, voffA); PG8_STAGE(PG8_SB(0, 1), cB + hstep, voffB); PG8_STAGE(PG8_SA(0, 1), cA + hstep, voffA);
        if (wr == 1) PG8_BAR;
        PG8_WAIT_V(4); PG8_BAR;
        PG8_STAGE(PG8_SB(1, 0), cB + kstep, voffB); PG8_STAGE(PG8_SA(1, 0), cA + kstep, voffA); PG8_STAGE(PG8_SB(1, 1), cB + hstep + kstep, voffB);
        PG8_WAIT_V(6); PG8_BAR;
    }
    for (;;) {
        const bool has_next = S.next(ui + 1, nxt);
        const char* nA = has_next ? (const char*)g.A + (size_t)nxt.pm * tstep : cA; const char* nB = has_next ? (const char*)g.Bt + (size_t)nxt.pn * tstep : cB;
        for (int t = 0; t < nt; t += 2) {
            const bool last = (t == nt - 2);
            const char* a1 = cA + (size_t)(t + 1) * kstep;
            const char* a2 = last ? nA : cA + (size_t)(t + 2) * kstep; const char* b2 = last ? nB : cB + (size_t)(t + 2) * kstep;
            const char* a3 = a2 + kstep; const char* b3 = b2 + kstep;
            if (last && has_next) S.a_ready(nxt);
            if constexpr (SP2) {
            PG8_LDB(B0, 0, 0); PG8_LDB(B1, 0, 1); PG8_SCHED; PG8_LDA(At, 0, 0); PG8_STAGE(PG8_SA(1, 1), a1 + hstep, voffA);
            PG8_WAIT_V(8); PG8_WAIT_L(0); PG8_BAR; PG8_MMA(0, 0, At, B0); PG8_MMA(0, 1, At, B1); PG8_BAR; PG8_SCHED;
            PG8_LDA(At, 0, 1); PG8_STAGE(PG8_SB(0, 0), b2, voffB); PG8_STAGE(PG8_SB(0, 1), b2 + hstep, voffB); PG8_STAGE(PG8_SA(0, 0), a2, voffA);
            PG8_WAIT_V(8); PG8_WAIT_L(0); PG8_BAR; PG8_MMA(1, 0, At, B0); PG8_MMA(1, 1, At, B1); PG8_BAR; PG8_SCHED;
            PG8_LDB(B0, 1, 0); PG8_LDB(B1, 1, 1); PG8_SCHED; PG8_LDA(At, 1, 0); PG8_STAGE(PG8_SA(0, 1), a2 + hstep, voffA);
            PG8_WAIT_V(8); PG8_WAIT_L(0); PG8_BAR; PG8_MMA(0, 0, At, B0); PG8_MMA(0, 1, At, B1); PG8_BAR; PG8_SCHED;
            PG8_LDA(At, 1, 1); PG8_STAGE(PG8_SB(1, 0), b3, voffB); PG8_STAGE(PG8_SB(1, 1), b3 + hstep, voffB); PG8_STAGE(PG8_SA(1, 0), a3, voffA);
            PG8_WAIT_V(8); PG8_WAIT_L(0); PG8_BAR; PG8_MMA(1, 0, At, B0); PG8_MMA(1, 1, At, B1); PG8_BAR; PG8_SCHED;
            } else {
            PG8_LDB(B0, 0, 0); PG8_SCHED; PG8_LDA(At, 0, 0); PG8_STAGE(PG8_SA(1, 1), a1 + hstep, voffA);
            PG8_WAIT_L(8); PG8_BAR; PG8_WAIT_L(0); PG8_MMA(0, 0, At, B0); PG8_BAR; PG8_SCHED;
            PG8_LDB(B1, 0, 1); PG8_STAGE(PG8_SB(0, 0), b2, voffB);
            PG8_BAR; PG8_WAIT_L(0); PG8_MMA(0, 1, At, B1); PG8_BAR;
            PG8_LDA(At, 0, 1); PG8_STAGE(PG8_SA(0, 0), a2, voffA);
            PG8_BAR; PG8_WAIT_L(0); PG8_MMA(1, 0, At, B0); PG8_BAR; PG8_SCHED;
            PG8_STAGE(PG8_SB(0, 1), b2 + hstep, voffB);
            PG8_WAIT_V(6); PG8_BAR; PG8_MMA(1, 1, At, B1); PG8_BAR;
            PG8_LDB(B0, 1, 0); PG8_SCHED; PG8_LDA(At, 1, 0); PG8_STAGE(PG8_SA(0, 1), a2 + hstep, voffA);
            PG8_WAIT_L(8); PG8_BAR; PG8_WAIT_L(0); PG8_MMA(0, 0, At, B0); PG8_BAR; PG8_SCHED;
            PG8_LDB(B1, 1, 1); PG8_STAGE(PG8_SB(1, 0), b3, voffB);
            PG8_BAR; PG8_WAIT_L(0); PG8_MMA(0, 1, At, B1); PG8_BAR;
            PG8_LDA(At, 1, 1); PG8_STAGE(PG8_SA(1, 0), a3, voffA);
            PG8_BAR; PG8_WAIT_L(0); PG8_MMA(1, 0, At, B0); PG8_BAR; PG8_SCHED;
            PG8_STAGE(PG8_SB(1, 1), b3 + hstep, voffB);
            PG8_WAIT_V(6); PG8_BAR; PG8_MMA(1, 1, At, B1); PG8_BAR;
            }
        }
        if constexpr (ALIGN_EPI) { if (wr == 0) PG8_BAR; }
        if constexpr (!Epi::AFTER_DRAIN) { E(acc, cur, wr, wc, fr, fq); S.done(cur); }
        if (!has_next) break;
#pragma unroll
        for (int a = 0; a < 2; ++a)
#pragma unroll
            for (int b = 0; b < 2; ++b)
#pragma unroll
                for (int m = 0; m < 4; ++m)
#pragma unroll
                    for (int n = 0; n < 2; ++n) acc[a][b][m][n] = (f32x4){0.f, 0.f, 0.f, 0.f};
        cur = nxt; cA = nA; cB = nB; ++ui;
        if constexpr (ALIGN_EPI) { if (wr == 1) PG8_BAR; }
    }
    PG8_WAIT_V(0);
    if constexpr (!ALIGN_EPI) { if (wr == 0) PG8_BAR; }
    PG8_BAR;
    if constexpr (Epi::AFTER_DRAIN) { E.fused(acc, cur, wr, wc, fr, fq, lds, wid, lane); S.done(cur); }
#undef PG8_SA
#undef PG8_SB
#undef PG8_STAGE
#undef PG8_LDA
#undef PG8_LDB
#undef PG8_MMA
#undef PG8_WAIT_V
#undef PG8_WAIT_L
#undef PG8_BAR
#undef PG8_SCHED
}
}
namespace cg = cooperative_groups;
#define GAS __attribute__((address_space(1)))
#define LAS __attribute__((address_space(3)))
typedef unsigned short bf16;
typedef unsigned v4u __attribute__((ext_vector_type(4)));
typedef unsigned v2u __attribute__((ext_vector_type(2)));
typedef float f32x4 __attribute__((ext_vector_type(4)));
typedef short bf16x8 __attribute__((ext_vector_type(8)));

constexpr int NB = 8, SEQ = 2048, DM = 1024, DEPTH = 4, MTOK = NB * SEQ;
constexpr int INC = 9216, ADAC = 3072, MIXW = 2048;
constexpr int C_QH = 0, C_IH = 1024, C_ZFW = 2048, C_ZBW = 3072, C_GH = 4096, C_QN = 5120, C_KN = 6144, C_VN = 7168, C_GN = 8192;
constexpr float DN_ALPHA = 1.6817928305074290f;
constexpr float LN_EPS = 1e-5f, RMS_EPS = 1e-6f;

constexpr size_t MiB = 1u << 20;
constexpr size_t WS_CTL = 0, CTL_ZERO_BYTES = 1 * MiB;
constexpr size_t WS_MOD = 1 * MiB;
constexpr size_t WS_LB = 1 * MiB + 512 * 1024;
constexpr size_t WS_WTIN = 2 * MiB;
constexpr size_t WS_WTOUT = 74 * MiB;
constexpr size_t WS_H = 90 * MiB;
constexpr size_t WS_P = 122 * MiB;
constexpr size_t WS_Y = 410 * MiB;
constexpr size_t WS_OBUF = 474 * MiB;
constexpr size_t WS_OB2 = 538 * MiB;
constexpr size_t WS_END = 570 * MiB;
constexpr int CW_BAR = 65536;
constexpr int CW_HG = 1024;

constexpr int LDS_BYTES = 155648;
constexpr int LDS_FLAG = 155648 - 64;
constexpr int NPHASE = 2 + 4 * DEPTH;

__device__ __forceinline__ float bf2f(bf16 v) { return __uint_as_float((unsigned)v << 16); }
__device__ __forceinline__ unsigned f2bf(float f) { unsigned u = __float_as_uint(f); return (u + 0x7fffu + ((u >> 16) & 1u)) >> 16; }
typedef __bf16 bf2_t __attribute__((ext_vector_type(2)));
typedef float f2_t __attribute__((ext_vector_type(2)));
__device__ __forceinline__ unsigned pk2(float lo, float hi) { const f2_t v = {lo, hi}; return __builtin_bit_cast(unsigned, __builtin_convertvector(v, bf2_t)); }
__device__ __forceinline__ float wave_sum(float v) {
#pragma unroll
    for (int o = 1; o < 64; o <<= 1) v += __shfl_xor(v, o);
    return v;
}
__device__ __forceinline__ float wave_max(float v) {
#pragma unroll
    for (int o = 1; o < 64; o <<= 1) v = fmaxf(v, __shfl_xor(v, o));
    return v;
}
__device__ __forceinline__ float sigmoidf_(float z) { return __builtin_amdgcn_rcpf(1.0f + __builtin_amdgcn_exp2f(-1.4426950408889634f * z)); }

struct Args { const float* in[11]; float* out; unsigned char* ws; int ph_lo, ph_hi, coop, pad; };

__device__ __forceinline__ void p0_transpose_item(const float* W, int K, int N, bf16* WT, LAS float* scr, int item, int lane) {
    const int nblk = N / 32, kb = item / nblk, nb = item % nblk, k0 = 64 * kb, n0 = 32 * nb;
#pragma unroll 8
    for (int i = 0; i < 32; ++i) { const int kk = 2 * i + (lane >> 5); scr[kk * 33 + (lane & 31)] = W[(size_t)(k0 + kk) * N + n0 + (lane & 31)]; }
    asm volatile("s_waitcnt lgkmcnt(0)" ::: "memory");
    const int c = lane & 7;
#pragma unroll
    for (int j = 0; j < 4; ++j) { const int n = (lane >> 3) + 8 * j; const LAS float* s = scr + (8 * c) * 33 + n;
        v4u o; o.x = pk2(s[0 * 33], s[1 * 33]); o.y = pk2(s[2 * 33], s[3 * 33]); o.z = pk2(s[4 * 33], s[5 * 33]); o.w = pk2(s[6 * 33], s[7 * 33]);
        *(v4u*)(WT + (size_t)(n0 + n) * K + k0 + 8 * c) = o; }
    asm volatile("s_waitcnt lgkmcnt(0)" ::: "memory");
}

struct EpiZ {
    static constexpr bool PERM = false, AFTER_DRAIN = false;
    const float* xin; float* out; const float* gate;
    __device__ __forceinline__ void operator()(const pg8::f32x4 (&acc)[2][2][4][2], const pg8::Unit& u, int wr, int wc, int fr, int fq) const {
        const int col0 = u.pn * 256 + wc * 32 + 4 * fq;
        const float* g = gate + (size_t)(u.pm >> 3) * ADAC;
#pragma unroll
        for (int ai = 0; ai < 2; ++ai)
#pragma unroll
            for (int m = 0; m < 4; ++m) { const size_t r = (size_t)u.pm * 256 + ai * 128 + wr * 64 + m * 16 + fr;
#pragma unroll
                for (int bj = 0; bj < 2; ++bj)
#pragma unroll
                    for (int n = 0; n < 2; ++n) { const int c = col0 + bj * 128 + n * 16;
                        const f32x4 g4 = *(const f32x4*)(g + c); const f32x4 xv = *(const f32x4*)(xin + r * DM + c);
                        const pg8::f32x4 av = acc[ai][bj][m][n];
                        f32x4 o; o.x = DN_ALPHA * xv.x + g4.x * av[0]; o.y = DN_ALPHA * xv.y + g4.y * av[1]; o.z = DN_ALPHA * xv.z + g4.z * av[2]; o.w = DN_ALPHA * xv.w + g4.w * av[3];
                        *(f32x4*)(out + r * DM + c) = o; } }
    }
};

typedef GAS unsigned gu32;
#define XB_TMO      128
#define XB_XCNT(j)  (256  + 64 * (j))
#define XB_XSUB(j)  (1280 + 64 * (j))
#define XB_XGEN(j)  (2304 + 64 * (j))
#define XB_TOP      3328
#define XB_TOPGEN   3392
#define XCD_BAR_WORDS 3456
#define XB_SPIN_CAP (1u << 18)

__device__ __forceinline__ unsigned xb_ld(unsigned* p)              { return __hip_atomic_load(p, __ATOMIC_RELAXED, __HIP_MEMORY_SCOPE_AGENT); }
__device__ __forceinline__ unsigned xb_add(unsigned* p, unsigned v) { return __hip_atomic_fetch_add(p, v, __ATOMIC_RELAXED, __HIP_MEMORY_SCOPE_AGENT); }
__device__ __forceinline__ unsigned xb_xcc_id() { return (unsigned)__builtin_amdgcn_s_getreg((3 << 11) | 20) & 0xFu; }
#define XB_SPIN(cond, bar) do { unsigned _sp = 0; while (cond) { __builtin_amdgcn_s_sleep(1); \
    if ((++_sp & 255u) == 0u) { if (xb_ld(&(bar)[XB_TMO])) break; if (_sp > XB_SPIN_CAP) { atomicAdd(&(bar)[XB_TMO], 1u); break; } } } } while (0)

struct XcdBarrier {
    unsigned* bar; unsigned x;
    volatile LAS unsigned* st;
};

__device__ __forceinline__ XcdBarrier xcd_barrier_post(unsigned* bar, volatile LAS unsigned* st) {
    XcdBarrier b; b.bar = bar; b.x = xb_xcc_id(); b.st = st;
    if (threadIdx.x == 0) (void)xb_add(&bar[XB_XCNT(b.x)], 1u);
    return b;
}
__device__ __forceinline__ void xcd_barrier_complete(unsigned* bar, unsigned x, unsigned& nloc, unsigned& nx) {
    const unsigned G = gridDim.x * gridDim.y * gridDim.z;
    unsigned sum, cnt, mine, sp = 0u;
    for (;;) {
        sum = 0u; cnt = 0u; mine = 0u;
#pragma unroll
        for (unsigned j = 0; j < 16; ++j) { const unsigned c = xb_ld(&bar[XB_XCNT(j)]); sum += c; cnt += (c > 0u) ? 1u : 0u; mine = (j == x) ? c : mine; }
        if (sum == G) break;
        __builtin_amdgcn_s_sleep(1);
        if ((++sp & 255u) == 0u) { if (xb_ld(&bar[XB_TMO])) break; if (sp > XB_SPIN_CAP) { atomicAdd(&bar[XB_TMO], 1u); break; } }
    }
    nloc = mine > 0u ? mine : 1u; nx = cnt > 0u ? cnt : 1u;
}

__device__ __forceinline__ void xcd_barrier(const XcdBarrier& b) {
    asm volatile("s_waitcnt vmcnt(0)" ::: "memory");
    __syncthreads();
    if (threadIdx.x == 0) {
        unsigned* bar = b.bar;
        __builtin_amdgcn_s_waitcnt(0);
        unsigned nloc = b.st[0], nx = b.st[1];
        if (nloc == 0u) { xcd_barrier_complete(bar, b.x, nloc, nx); b.st[0] = nloc; b.st[1] = nx; }
        const unsigned old = xb_add(&bar[XB_XSUB(b.x)], 1u);
        const unsigned gen = old / nloc;
        if (old + 1u == (gen + 1u) * nloc) {
            __builtin_amdgcn_fence(__ATOMIC_RELEASE, "agent");
            asm volatile("s_waitcnt vmcnt(0)" ::: "memory");
            const unsigned og = xb_add(&bar[XB_TOP], 1u);
            const unsigned tg = og / nx;
            if (og + 1u == (tg + 1u) * nx) xb_add(&bar[XB_TOPGEN], 1u);
            else XB_SPIN(xb_ld(&bar[XB_TOPGEN]) == tg, bar);
            __builtin_amdgcn_fence(__ATOMIC_ACQUIRE, "agent");
            xb_add(&bar[XB_XGEN(b.x)], 1u);
            asm volatile("s_waitcnt vmcnt(0)" ::: "memory");
        } else {
            XB_SPIN(xb_ld(&bar[XB_XGEN(b.x)]) == gen, bar);
            __builtin_amdgcn_fence(__ATOMIC_ACQUIRE, "agent");
            asm volatile("s_waitcnt vmcnt(0)" ::: "memory");
        }
    }
    __syncthreads();
}

struct Ctx {
    LAS unsigned char* lds; int tid, lane, wave;
    const Args* a; XcdBarrier bar;
    __device__ __forceinline__ const float* in(int k) const { return a->in[k]; }
    __device__ __forceinline__ unsigned char* wsp() const { return a->ws; }
#define CTXP(name, expr) __device__ __forceinline__ auto name() const { return expr; }
    CTXP(x, in(0)) CTXP(c, in(1)) CTXP(ada_w, in(2)) CTXP(ada_b, in(3)) CTXP(w_in, in(4)) CTXP(lb_logits, in(5)) CTXP(hg_norm_g, in(6))
    CTXP(rpb, in(7)) CTXP(w_out, in(8)) CTXP(ln_g, in(9)) CTXP(ln_b, in(10)) CTXP(out, a->out)
    CTXP(mod, (float*)(wsp() + WS_MOD)) CTXP(lb, (float*)(wsp() + WS_LB)) CTXP(wt_in, (bf16*)(wsp() + WS_WTIN)) CTXP(wt_out, (bf16*)(wsp() + WS_WTOUT))
    CTXP(H, (bf16*)(wsp() + WS_H)) CTXP(P, (bf16*)(wsp() + WS_P)) CTXP(Y, (bf16*)(wsp() + WS_Y)) CTXP(obuf, (float*)(wsp() + WS_OBUF))
#undef CTXP
};

__device__ __forceinline__ void phase_prologue(Ctx& F) {
    LAS float* scr = (LAS float*)(F.lds + F.wave * 16384);
    const int gw = blockIdx.x * 8 + F.wave, NGW = gridDim.x * 8;
    constexpr int I_IN = (DM / 64) * (INC / 32), I_OUT = (MIXW / 64) * (DM / 32);
    for (int it = gw; it < DEPTH * (I_IN + I_OUT); it += NGW) {
        int l = it / (I_IN + I_OUT), r = it % (I_IN + I_OUT);
        if (r < I_IN) p0_transpose_item(F.w_in() + (size_t)l * DM * INC, DM, INC, F.wt_in() + (size_t)l * INC * DM, scr, r, F.lane);
        else p0_transpose_item(F.w_out() + (size_t)l * MIXW * DM, MIXW, DM, F.wt_out() + (size_t)l * DM * MIXW, scr, r - I_IN, F.lane);
    }
    __syncthreads();
    LAS float* sc = (LAS float*)F.lds;
    LAS float* red = (LAS float*)(F.lds + 32768);
    for (int it = blockIdx.x; it < DEPTH * (ADAC / 64); it += gridDim.x) {
        const int l = it / (ADAC / 64), j0 = (it % (ADAC / 64)) * 64;
        for (int i = F.tid; i < NB * DM; i += 512) { const float v = F.c()[i]; sc[i] = v * sigmoidf_(v); }
        __syncthreads();
        const int kq = F.tid >> 6, jj = F.tid & 63;
        float acc[8];
#pragma unroll
        for (int b = 0; b < 8; ++b) acc[b] = 0.f;
        const float* w = F.ada_w() + (size_t)l * DM * ADAC + j0 + jj;
#pragma unroll 8
        for (int k = kq; k < DM; k += 8) { const float wv = w[(size_t)k * ADAC];
#pragma unroll
            for (int b = 0; b < 8; ++b) acc[b] += sc[b * DM + k] * wv; }
#pragma unroll
        for (int b = 0; b < 8; ++b) red[(kq * 8 + b) * 64 + jj] = acc[b];
        __syncthreads();
        { const int b = F.tid >> 6; float s = 0.f;
#pragma unroll
          for (int q = 0; q < 8; ++q) s += red[(q * 8 + b) * 64 + jj];
          F.mod()[((size_t)l * NB + b) * ADAC + j0 + jj] = s + F.ada_b()[l * ADAC + j0 + jj]; }
        __syncthreads();
    }
    if (blockIdx.x == 0) { unsigned* ctl = (unsigned*)(F.wsp() + WS_CTL); for (int i = F.tid; i < DEPTH * 64; i += 512) ctl[CW_HG + i * 64] = 0u; for (int i = F.tid; i < 3456; i += 512) ctl[CW_BAR + i] = 0u; }
    if (blockIdx.x == gridDim.x - 1) {
        for (int i = F.tid; i < 2 * 1024; i += 512) { const int ds = i >> 10, ch = i & 1023;
            float lg[4], mx = -1e30f;
#pragma unroll
            for (int l = 0; l < 4; ++l) { lg[l] = F.lb_logits()[(ds * 4 + l) * 1024 + ch]; mx = fmaxf(mx, lg[l]); }
            float s = 0.f;
#pragma unroll
            for (int l = 0; l < 4; ++l) { lg[l] = __expf(lg[l] - mx); s += lg[l]; }
            const float inv = 1.f / s; float cs = 0.f;
            F.lb()[(ds * 4 + 0) * 1024 + ch] = 0.f;
#pragma unroll
            for (int l = 1; l < 4; ++l) { cs += lg[l] * inv; F.lb()[(ds * 4 + l) * 1024 + ch] = cs; }
        }
    }
}

__device__ __forceinline__ void ln_mod_row(const float* xrow, const float* modb  , bf16* orow, int lane) {
    const f32x4* xr = (const f32x4*)xrow + lane;
    f32x4 v[4]; float s = 0.f;
#pragma unroll
    for (int j = 0; j < 4; ++j) { v[j] = xr[64 * j]; s += (v[j].x + v[j].y) + (v[j].z + v[j].w); }
    const float mean = wave_sum(s) * (1.f / DM); float s2 = 0.f;
#pragma unroll
    for (int j = 0; j < 4; ++j) { v[j] = v[j] - mean; s2 += (v[j].x * v[j].x + v[j].y * v[j].y) + (v[j].z * v[j].z + v[j].w * v[j].w); }
    const float rstd = 1.f / sqrtf(wave_sum(s2) * (1.f / DM) + LN_EPS);
    unsigned long long* o8 = (unsigned long long*)orow + lane;
#pragma unroll
    for (int j = 0; j < 4; ++j) { const f32x4 sh = *((const f32x4*)modb + lane + 64 * j), sc = *((const f32x4*)(modb + DM) + lane + 64 * j);
        const float a = v[j].x * rstd * (1.f + sc.x) + sh.x, b = v[j].y * rstd * (1.f + sc.y) + sh.y, c = v[j].z * rstd * (1.f + sc.z) + sh.z, d = v[j].w * rstd * (1.f + sc.w) + sh.w;
        o8[64 * j] = (unsigned long long)pk2(a, b) | ((unsigned long long)pk2(c, d) << 32); }
}
__device__ __forceinline__ void phase_ln0(Ctx& F) {
    const int gw = blockIdx.x * 8 + F.wave, NGW = gridDim.x * 8;
    for (int m = gw; m < MTOK; m += NGW) ln_mod_row(F.x() + (size_t)m * DM, F.mod() + (size_t)(0 * NB + (m >> 11)) * ADAC, F.H() + (size_t)m * DM, F.lane);
}
__device__ __forceinline__ void phase_ln(Ctx& F, int l) {
    const int gw = blockIdx.x * 8 + F.wave, NGW = gridDim.x * 8;
    for (int m = gw; m < MTOK; m += NGW) {
        f32x4* xr = (f32x4*)(F.out() + (size_t)m * DM) + F.lane;
        f32x4 v[4]; float s = 0.f;
#pragma unroll
        for (int j = 0; j < 4; ++j) { v[j] = xr[64 * j]; s += (v[j].x + v[j].y) + (v[j].z + v[j].w); }
        const float mean = wave_sum(s) * (1.f / DM); float s2 = 0.f;
#pragma unroll
        for (int j = 0; j < 4; ++j) { v[j] = v[j] - mean; s2 += (v[j].x * v[j].x + v[j].y * v[j].y) + (v[j].z * v[j].z + v[j].w * v[j].w); }
        const float rstd = 1.f / sqrtf(wave_sum(s2) * (1.f / DM) + LN_EPS);
        float t = 0.f;
#pragma unroll
        for (int j = 0; j < 4; ++j) { const f32x4 g = *((const f32x4*)(F.ln_g() + l * DM) + F.lane + 64 * j), b = *((const f32x4*)(F.ln_b() + l * DM) + F.lane + 64 * j);
            v[j].x = v[j].x * rstd * g.x + b.x; v[j].y = v[j].y * rstd * g.y + b.y; v[j].z = v[j].z * rstd * g.z + b.z; v[j].w = v[j].w * rstd * g.w + b.w;
            xr[64 * j] = v[j]; t += (v[j].x + v[j].y) + (v[j].z + v[j].w); }
        if (l + 1 < DEPTH) {
            const float mean2 = wave_sum(t) * (1.f / DM); float t2 = 0.f;
#pragma unroll
            for (int j = 0; j < 4; ++j) { v[j] = v[j] - mean2; t2 += (v[j].x * v[j].x + v[j].y * v[j].y) + (v[j].z * v[j].z + v[j].w * v[j].w); }
            const float rstd2 = 1.f / sqrtf(wave_sum(t2) * (1.f / DM) + LN_EPS);
            const float* modb = F.mod() + (size_t)((l + 1) * NB + (m >> 11)) * ADAC;
            unsigned long long* o8 = (unsigned long long*)(F.H() + (size_t)m * DM) + F.lane;
#pragma unroll
            for (int j = 0; j < 4; ++j) { const f32x4 sh = *((const f32x4*)modb + F.lane + 64 * j), sc = *((const f32x4*)(modb + DM) + F.lane + 64 * j);
                const float a = v[j].x * rstd2 * (1.f + sc.x) + sh.x, b = v[j].y * rstd2 * (1.f + sc.y) + sh.y, c = v[j].z * rstd2 * (1.f + sc.z) + sh.z, d = v[j].w * rstd2 * (1.f + sc.w) + sh.w;
                o8[64 * j] = (unsigned long long)pk2(a, b) | ((unsigned long long)pk2(c, d) << 32); }
        }
    }
}

__device__ __forceinline__ void hgrn_naive_unit(Ctx& F, int l, int bh) {
    const int b = bh >> 3, h = bh & 7, tid = F.tid;
    const bf16* Pb = F.P() + (size_t)b * SEQ * INC;
    LAS float* sq = (LAS float*)F.lds;
    LAS float* sf = sq + 16 * 128;
    LAS float* sk = sf + 16 * 128;
    LAS float* so = sk + 16 * 128;
    LAS float* srs = so + 16 * 128;
    const bool act = tid < 128;
    const int ch = h * 128 + (tid & 127);
    const float ng = F.hg_norm_g()[l * 128 + (tid & 127)];
    for (int pass = 1; pass >= 0; --pass) {
        float S[128];
#pragma unroll
        for (int d = 0; d < 128; ++d) S[d] = 0.f;
        const float lbv = F.lb()[(pass * 4 + l) * 1024 + ch];
        const int zc = pass ? C_ZBW : C_ZFW;
        for (int c = 0; c < SEQ / 16; ++c) {
            if (act) {
#pragma unroll 4
                for (int i = 0; i < 16; ++i) { const int tt = c * 16 + i, tok = pass ? (SEQ - 1 - tt) : tt; const bf16* row = Pb + (size_t)tok * INC;
                    const float q = bf2f(row[C_QH + ch]), z = bf2f(row[zc + ch]);
                    const float f = lbv + (1.f - lbv) * sigmoidf_(z);
                    sq[i * 128 + tid] = q; sf[i * 128 + tid] = f; sk[i * 128 + tid] = 1.f - f; }
            }
            __syncthreads();
            if (act) {
                for (int i = 0; i < 16; ++i) { const int tt = c * 16 + i, tok = pass ? (SEQ - 1 - tt) : tt; const bf16* row = Pb + (size_t)tok * INC;
                    const float vt = bf2f(row[C_IH + ch]); float o = 0.f;
#pragma unroll
                    for (int d = 0; d < 128; ++d) { S[d] = sf[i * 128 + d] * S[d] + sk[i * 128 + d] * vt; o += sq[i * 128 + d] * S[d]; }
                    float* op = F.obuf() + ((size_t)b * SEQ + tok) * 1024 + ch;
                    if (pass) *op = o; else so[i * 128 + tid] = o + *op; }
            }
            __syncthreads();
            if (pass == 0) {
                if (tid < 16) { float ss = 0.f; for (int d = 0; d < 128; ++d) { const float v = so[tid * 128 + d]; ss += v * v; } srs[tid] = 1.f / sqrtf(ss * (1.f / 128.f) + RMS_EPS); }
                __syncthreads();
                if (act) { for (int i = 0; i < 16; ++i) { const int tok = c * 16 + i; const bf16* row = Pb + (size_t)tok * INC;
                        const float g = bf2f(row[C_GH + ch]); const float y = so[i * 128 + tid] * srs[i] * ng * (g * sigmoidf_(g));
                        F.Y()[((size_t)b * SEQ + tok) * MIXW + ch] = (bf16)f2bf(y); } }
                __syncthreads();
            }
        }
    }
}
__device__ __forceinline__ void na_naive_items(Ctx& F, int l) {
    LAS float* sp = (LAS float*)(F.lds + 65536) + F.wave * 128;
    const int lane = F.lane;
    for (int it0 = blockIdx.x * 8; it0 < MTOK * 16; it0 += gridDim.x * 8) {
        const int it = it0 + F.wave;
        const int tokq = it >> 4, h = it & 15, b = tokq >> 11, r = (tokq >> 6) & 31, col = tokq & 63;
        const int rs = min(max(r - 4, 0), 24), cs = min(max(col - 8, 0), 48);
        const bf16* qrow = F.P() + (size_t)tokq * INC + C_QN + h * 64;
        float s2[2];
#pragma unroll
        for (int e = 0; e < 2; ++e) { const int kk = lane + 64 * e, kr = kk >> 4, kc = kk & 15; const int tokk = b * SEQ + (rs + kr) * 64 + cs + kc;
            const bf16* krow = F.P() + (size_t)tokk * INC + C_KN + h * 64; float dot = 0.f;
#pragma unroll
            for (int d8 = 0; d8 < 8; ++d8) { const v4u qa = *(const v4u*)(qrow + d8 * 8), ka = *(const v4u*)(krow + d8 * 8);
#pragma unroll
                for (int w = 0; w < 4; ++w) { dot += __uint_as_float(qa[w] << 16) * __uint_as_float(ka[w] << 16) + __uint_as_float(qa[w] & 0xffff0000u) * __uint_as_float(ka[w] & 0xffff0000u); } }
            const float bias = F.rpb()[(((size_t)l * 16 + h) * 15 + (rs + kr - r + 7)) * 31 + (cs + kc - col + 15)];
            s2[e] = dot * 0.125f + bias; }
        const float mx = wave_max(fmaxf(s2[0], s2[1]));
        const float p0 = __expf(s2[0] - mx), p1 = __expf(s2[1] - mx);
        const float sum = wave_sum(p0 + p1);
        sp[lane] = p0; sp[lane + 64] = p1;
        asm volatile("s_waitcnt lgkmcnt(0)" ::: "memory");
        float o = 0.f;
        for (int kk = 0; kk < 128; ++kk) { const int kr = kk >> 4, kc = kk & 15; const int tokk = b * SEQ + (rs + kr) * 64 + cs + kc;
            o += sp[kk] * bf2f(F.P()[(size_t)tokk * INC + C_VN + h * 64 + lane]); }
        const float g = bf2f(F.P()[(size_t)tokq * INC + C_GN + h * 64 + lane]);
        F.Y()[(size_t)tokq * MIXW + 1024 + h * 64 + lane] = (bf16)f2bf(o / sum * (g * sigmoidf_(g)));
        asm volatile("s_waitcnt lgkmcnt(0)" ::: "memory");
    }
}
__device__ __forceinline__ void phase_mix_naive(Ctx& F, int l) {
    for (int u = blockIdx.x; u < 64; u += gridDim.x) hgrn_naive_unit(F, l, u);
    __syncthreads();
    na_naive_items(F, l);
}


typedef float hf32x4 __attribute__((ext_vector_type(4)));
constexpr int HG_RS = 272, HG_TS = 80;
constexpr int HG_QM = 0, HG_KM = 8704, HG_KMT = 17408, HG_VT = 27648, HG_C = 37888, HG_A = 38912, HG_CHUNK = 41472;
__device__ __forceinline__ float* hg_obw(Ctx& F, int b) { return b < 4 ? (float*)(F.wsp() + WS_H) + (size_t)b * SEQ * 1024 : (float*)(F.wsp() + WS_OB2) + (size_t)(b - 4) * SEQ * 1024; }
__device__ __forceinline__ bf16x8 ld_frag(LAS unsigned char* p) { return *(LAS bf16x8*)p; }
#define MFMA16(a, b, c) __builtin_amdgcn_mfma_f32_16x16x32_bf16((a), (b), (c), 0, 0, 0)

__device__ __forceinline__ void hgrn_unit(Ctx& F, int l, int unit) {
    const int dir = unit & 1, bh = unit >> 1, b = bh >> 3, h = bh & 7;
    const int lane = F.lane, wv = F.wave;
    LAS unsigned char* L = F.lds;
    const bf16* Pb = F.P() + (size_t)b * SEQ * INC;
    float* Ob = dir ? hg_obw(F, b) : F.obuf() + (size_t)b * SEQ * 1024;
    const int par = wv >> 2, cpg = (wv >> 1) & 1, qp = wv & 1;
    const int cp = 32 * cpg + (lane & 31), quarter = 2 * qp + (lane >> 5), t0 = 8 * quarter;
    const int ci = cp & 15, grp = cp >> 4;
    const int pi = (((ci >> 1) & 3) << 2) | (((ci >> 3) & 1) << 1) | (ci & 1);
    const int chA = h * 128 + 2 * cp;
    const float lb0 = F.lb()[(dir * 4 + l) * 1024 + chA], lb1 = F.lb()[(dir * 4 + l) * 1024 + chA + 1];
    const int zc = dir ? C_ZBW : C_ZFW;
    LAS unsigned char* Lp = L + par * HG_CHUNK;
    const int fr = lane & 15, g = lane >> 4;
    unsigned rq[8], rz[8], rv[8];
#define HG_LOAD_RAW(R) do { _Pragma("unroll") for (int i = 0; i < 8; ++i) { const int p_ = 32 * (2 * (R) + par) + t0 + i; const int tok_ = dir ? (SEQ - 1 - p_) : p_; \
        const bf16* row_ = Pb + (size_t)tok_ * INC + chA; rq[i] = *(const unsigned*)(row_ + C_QH); rz[i] = *(const unsigned*)(row_ + zc); rv[i] = *(const unsigned*)(row_ + C_IH); } } while (0)
    HG_LOAD_RAW(0);
    hf32x4 T[8];
#pragma unroll
    for (int mt = 0; mt < 8; ++mt) T[mt] = (hf32x4){0.f, 0.f, 0.f, 0.f};
    for (int R = 0; R < SEQ / 64; ++R) {
        {
            float qm[2][8], km[2][8]; float tot[2];
#pragma unroll
            for (int e = 0; e < 2; ++e) {
                const float lbe = e ? lb1 : lb0;
                float q[8], f[8], k[8];
#pragma unroll
                for (int i = 0; i < 8; ++i) { q[i] = e ? __uint_as_float(rq[i] & 0xffff0000u) : __uint_as_float(rq[i] << 16);
                    const float z = e ? __uint_as_float(rz[i] & 0xffff0000u) : __uint_as_float(rz[i] << 16);
                    const float sg = sigmoidf_(z); f[i] = lbe + (1.f - lbe) * sg; k[i] = 1.f - f[i]; }
                if (qp == 0) {
                    float Rl[8]; Rl[7] = 1.f;
#pragma unroll
                    for (int i = 6; i >= 0; --i) Rl[i] = Rl[i + 1] * f[i + 1];
                    const float tt = Rl[0] * f[0]; const float oth = __shfl_xor(tt, 32); const float mult = (lane < 32) ? oth : 1.f;
#pragma unroll
                    for (int i = 0; i < 8; ++i) { const float Rv = Rl[i] * mult; qm[e][i] = q[i] * __builtin_amdgcn_rcpf(Rv); km[e][i] = k[i] * Rv; }
                    tot[e] = tt * oth;
                } else {
                    float El[8]; El[0] = f[0];
#pragma unroll
                    for (int i = 1; i < 8; ++i) El[i] = El[i - 1] * f[i];
                    const float tt = El[7]; const float oth = __shfl_xor(tt, 32); const float mult = (lane >= 32) ? oth : 1.f;
#pragma unroll
                    for (int i = 0; i < 8; ++i) { const float Ev = El[i] * mult; qm[e][i] = q[i] * Ev; km[e][i] = k[i] * __builtin_amdgcn_rcpf(Ev); }
                    tot[e] = tt * oth;
                }
            }
#pragma unroll
            for (int i = 0; i < 8; ++i) {
                *(LAS unsigned*)(Lp + HG_QM + (t0 + i) * HG_RS + (grp * 16 + pi) * 4) = pk2(qm[0][i], qm[1][i]);
                *(LAS unsigned*)(Lp + HG_KM + (t0 + i) * HG_RS + (grp * 16 + pi) * 4) = pk2(km[0][i], km[1][i]);
            }
#pragma unroll
            for (int e = 0; e < 2; ++e) {
                v4u kk, vv;
                kk.x = pk2(km[e][0], km[e][1]); kk.y = pk2(km[e][2], km[e][3]); kk.z = pk2(km[e][4], km[e][5]); kk.w = pk2(km[e][6], km[e][7]);
                if (e == 0) { vv.x = (rv[0] & 0xffffu) | (rv[1] << 16); vv.y = (rv[2] & 0xffffu) | (rv[3] << 16); vv.z = (rv[4] & 0xffffu) | (rv[5] << 16); vv.w = (rv[6] & 0xffffu) | (rv[7] << 16); }
                else        { vv.x = (rv[0] >> 16) | (rv[1] & 0xffff0000u); vv.y = (rv[2] >> 16) | (rv[3] & 0xffff0000u); vv.z = (rv[4] >> 16) | (rv[5] & 0xffff0000u); vv.w = (rv[6] >> 16) | (rv[7] & 0xffff0000u); }
                *(LAS v4u*)(Lp + HG_KMT + (2 * cp + e) * HG_TS + quarter * 16) = kk;
                *(LAS v4u*)(Lp + HG_VT + (2 * cp + e) * HG_TS + quarter * 16) = vv;
            }
            if (quarter == 0) { *(LAS float*)(Lp + HG_C + (2 * cp) * 4) = tot[0]; *(LAS float*)(Lp + HG_C + (2 * cp + 1) * 4) = tot[1]; }
            if (quarter == 3) { *(LAS float*)(Lp + HG_C + 512 + (2 * cp) * 4) = tot[0]; *(LAS float*)(Lp + HG_C + 512 + (2 * cp + 1) * 4) = tot[1]; }
        }
        if (R + 1 < SEQ / 64) HG_LOAD_RAW(R + 1);
        __syncthreads();
        {
            LAS unsigned char* La = L + (wv >> 2) * HG_CHUNK; const int tile = wv & 3, ti = tile >> 1, si = tile & 1;
            v2u w2;
            if (tile == 1) { w2.x = 0u; w2.y = 0u; }
            else {
                hf32x4 acc = (hf32x4){0.f, 0.f, 0.f, 0.f};
#pragma unroll
                for (int u = 0; u < 4; ++u) { const bf16x8 a = ld_frag(La + HG_KM + (16 * si + fr) * HG_RS + u * 64 + g * 16), bq = ld_frag(La + HG_QM + (16 * ti + fr) * HG_RS + u * 64 + g * 16);
                    acc = MFMA16(a, bq, acc); }
                const int tt = 16 * ti + fr, s0 = 16 * si + 4 * g;
                const float a0 = (s0 + 0 <= tt) ? acc[0] : 0.f, a1 = (s0 + 1 <= tt) ? acc[1] : 0.f, a2 = (s0 + 2 <= tt) ? acc[2] : 0.f, a3 = (s0 + 3 <= tt) ? acc[3] : 0.f;
                w2.x = pk2(a0, a1); w2.y = pk2(a2, a3);
            }
            *(LAS v2u*)(La + HG_A + (16 * ti + fr) * HG_TS + (16 * si + 4 * g) * 2) = w2;
        }
        __syncthreads();
#pragma unroll
        for (int cpar = 0; cpar < 2; ++cpar) {
            LAS unsigned char* Lc = L + cpar * HG_CHUNK; const int n = 2 * R + cpar;
#pragma unroll
            for (int mt = 0; mt < 8; ++mt) { const hf32x4 cv = *(LAS hf32x4*)(Lc + HG_C + (16 * mt + 4 * g) * 4); T[mt] = T[mt] * cv; }
            bf16x8 Tb[4];
#pragma unroll
            for (int u = 0; u < 4; ++u) { v4u t4; t4.x = pk2(T[2 * u][0], T[2 * u][1]); t4.y = pk2(T[2 * u][2], T[2 * u][3]); t4.z = pk2(T[2 * u + 1][0], T[2 * u + 1][1]); t4.w = pk2(T[2 * u + 1][2], T[2 * u + 1][3]);
                Tb[u] = __builtin_bit_cast(bf16x8, t4); }
            const bf16x8 vfrag = ld_frag(Lc + HG_VT + (16 * wv + fr) * HG_TS + g * 16);
            hf32x4 o[2];
#pragma unroll
            for (int ti = 0; ti < 2; ++ti) { o[ti] = (hf32x4){0.f, 0.f, 0.f, 0.f};
#pragma unroll
                for (int u = 0; u < 4; ++u) { const bf16x8 a = ld_frag(Lc + HG_QM + (16 * ti + fr) * HG_RS + u * 64 + g * 16); o[ti] = MFMA16(a, Tb[u], o[ti]); }
                const bf16x8 aa = ld_frag(Lc + HG_A + (16 * ti + fr) * HG_TS + g * 16); o[ti] = MFMA16(aa, vfrag, o[ti]); }
#pragma unroll
            for (int ti = 0; ti < 2; ++ti)
#pragma unroll
                for (int r = 0; r < 4; ++r) { const int p_ = 32 * n + 16 * ti + 4 * g + r; const int tok_ = dir ? (SEQ - 1 - p_) : p_; Ob[(size_t)tok_ * 1024 + h * 128 + 16 * wv + fr] = o[ti][r]; }
#pragma unroll
            for (int mt = 0; mt < 8; ++mt) { const bf16x8 a = ld_frag(Lc + HG_KMT + (16 * mt + fr) * HG_TS + g * 16); T[mt] = MFMA16(a, vfrag, T[mt]); }
#pragma unroll
            for (int mt = 0; mt < 8; ++mt) { const hf32x4 cv = *(LAS hf32x4*)(Lc + HG_C + 512 + (16 * mt + 4 * g) * 4); T[mt] = T[mt] * cv; }
        }
        __syncthreads();
    }
#undef HG_LOAD_RAW
}
__device__ __forceinline__ void hgrn_finalize(Ctx& F, int l, int bh) {
    const int b = bh >> 3, h = bh & 7, lane = F.lane, tq = lane >> 4, cl = lane & 15;
    const float* Of = F.obuf() + (size_t)b * SEQ * 1024; const float* Obw = hg_obw(F, b);
    const f32x4 ng0 = *(const f32x4*)(F.hg_norm_g() + l * 128 + 8 * cl), ng1 = *(const f32x4*)(F.hg_norm_g() + l * 128 + 8 * cl + 4);
    for (int t4 = F.wave; t4 < SEQ / 4; t4 += 8) {
        const int tok = 4 * t4 + tq; const size_t off = (size_t)tok * 1024 + h * 128 + 8 * cl;
        f32x4 a0 = *(const f32x4*)(Of + off), a1 = *(const f32x4*)(Of + off + 4); const f32x4 b0 = *(const f32x4*)(Obw + off), b1 = *(const f32x4*)(Obw + off + 4);
        a0 = a0 + b0; a1 = a1 + b1;
        float ss = (a0.x * a0.x + a0.y * a0.y) + (a0.z * a0.z + a0.w * a0.w) + (a1.x * a1.x + a1.y * a1.y) + (a1.z * a1.z + a1.w * a1.w);
        ss += __shfl_xor(ss, 1); ss += __shfl_xor(ss, 2); ss += __shfl_xor(ss, 4); ss += __shfl_xor(ss, 8);
        const float rs = 1.f / sqrtf(ss * (1.f / 128.f) + RMS_EPS);
        const v4u gq = *(const v4u*)(F.P() + ((size_t)b * SEQ + tok) * INC + C_GH + h * 128 + 8 * cl);
        float gv[8];
#pragma unroll
        for (int w = 0; w < 4; ++w) { gv[2 * w] = __uint_as_float(gq[w] << 16); gv[2 * w + 1] = __uint_as_float(gq[w] & 0xffff0000u); }
        float y[8];
        y[0] = a0.x * rs * ng0.x; y[1] = a0.y * rs * ng0.y; y[2] = a0.z * rs * ng0.z; y[3] = a0.w * rs * ng0.w;
        y[4] = a1.x * rs * ng1.x; y[5] = a1.y * rs * ng1.y; y[6] = a1.z * rs * ng1.z; y[7] = a1.w * rs * ng1.w;
#pragma unroll
        for (int w = 0; w < 8; ++w) y[w] *= gv[w] * sigmoidf_(gv[w]);
        v4u o; o.x = pk2(y[0], y[1]); o.y = pk2(y[2], y[3]); o.z = pk2(y[4], y[5]); o.w = pk2(y[6], y[7]);
        *(v4u*)(F.Y() + ((size_t)b * SEQ + tok) * MIXW + h * 128 + 8 * cl) = o;
    }
}

typedef short s16x4 __attribute__((ext_vector_type(4)));
constexpr int NA_K = 0, NA_V = 65536, NA_X = 131072, NA_RPB = NA_X + 4 * 64 * 18 * 4;
static_assert(NA_RPB + 465 * 4 <= LDS_FLAG, "NA LDS map");
constexpr float LOG2E = 1.4426950408889634f;
__device__ __forceinline__ void na_unit(Ctx& F, int l, int bh) {
    const int b = bh >> 4, h = bh & 15, lane = F.lane, wv = F.wave, tid = F.tid;
    const int j = wv & 3, kh = wv >> 2, fr = lane & 15, g = lane >> 4;
    LAS unsigned char* L = F.lds;
    const bf16* Pb = F.P() + (size_t)b * SEQ * INC;
    const int ks = (j == 0) ? 0 : (j == 1) ? 8 : (j == 2) ? 24 : 32;
    const int qcol = 16 * j + fr, cs = min(max(qcol - 8, 0), 48);
    LAS float* rpbl = (LAS float*)(L + NA_RPB);
    for (int i = tid; i < 465; i += 512) rpbl[i] = F.rpb()[((size_t)l * 16 + h) * 465 + i] * LOG2E;
    const int tokc = tid >> 3, chunk = tid & 7;
    const int kst = tokc * 128 + ((chunk ^ (tokc & 7)) << 4), vst = tokc * 128 + ((chunk ^ (((tokc >> 1) & 3) << 1)) << 4);
    const bf16* kvsrc = Pb + (size_t)tokc * INC + h * 64 + chunk * 8;
#pragma unroll 2
    for (int R = 0; R < 8; ++R) { const v4u kk = *(const v4u*)(kvsrc + (size_t)R * 64 * INC + C_KN), vv = *(const v4u*)(kvsrc + (size_t)R * 64 * INC + C_VN);
        *(LAS v4u*)(L + NA_K + R * 8192 + kst) = kk; *(LAS v4u*)(L + NA_V + R * 8192 + vst) = vv; }
    bf16x8 qf[2];
    { const bf16* qp_ = Pb + (size_t)(0 * 64 + qcol) * INC + C_QN + h * 64 + 8 * g; qf[0] = *(const bf16x8*)qp_; qf[1] = *(const bf16x8*)(qp_ + 32); }
    __syncthreads();
    float bias[4][2][4];
    int koff[2], voff[2];
#pragma unroll
    for (int ct = 0; ct < 2; ++ct) { const int col = ks + 16 * ct + fr; koff[ct] = col * 128 + ((g ^ (col & 7)) << 4);
        const int vcol = ks + 16 * ct + 4 * g + ((lane & 15) >> 2), p_ = lane & 3; voff[ct] = vcol * 128 + (((p_ >> 1) ^ (((vcol >> 1) & 3) << 1)) << 4) + (p_ & 1) * 8; }
    for (int r = 0; r < 32; ++r) {
        const int rs = min(max(r - 4, 0), 24);
        if (r <= 4 || r >= 29) { const int delta = rs - r + 7;
#pragma unroll
            for (int i = 0; i < 4; ++i)
#pragma unroll
                for (int ct = 0; ct < 2; ++ct)
#pragma unroll
                    for (int e = 0; e < 4; ++e) { const int kc = ks + 16 * ct + 4 * g + e; const bool inw = (kc >= cs) && (kc < cs + 16);
                        const int idx = (4 * kh + i + delta) * 31 + (kc - qcol + 15);
                        bias[i][ct][e] = inw ? rpbl[inw ? idx : 0] : -1e30f; } }
        const bool do_stage = (r >= 4) && (r <= 27);
        v4u kreg, vreg; bf16x8 qn[2];
        if (do_stage) { const size_t ro = (size_t)(r + 4) * 64 * INC; kreg = *(const v4u*)(kvsrc + ro + C_KN); vreg = *(const v4u*)(kvsrc + ro + C_VN); }
        if (r + 1 < 32) { const bf16* qp_ = Pb + (size_t)((r + 1) * 64 + qcol) * INC + C_QN + h * 64 + 8 * g; qn[0] = *(const bf16x8*)qp_; qn[1] = *(const bf16x8*)(qp_ + 32); }
        const size_t tokq = (size_t)b * SEQ + r * 64 + qcol;
        v2u gate[4];
        if (kh == 0) {
#pragma unroll
            for (int mt = 0; mt < 4; ++mt) gate[mt] = *(const v2u*)(F.P() + tokq * INC + C_GN + h * 64 + 16 * mt + 4 * g); }
        hf32x4 sacc[4][2];
#pragma unroll
        for (int i = 0; i < 4; ++i) { const int slot = (rs + 4 * kh + i) & 7;
#pragma unroll
            for (int ct = 0; ct < 2; ++ct) { hf32x4 a = (hf32x4){0.f, 0.f, 0.f, 0.f};
#pragma unroll
                for (int u = 0; u < 2; ++u) { const bf16x8 kf = ld_frag(L + NA_K + slot * 8192 + (koff[ct] ^ (u << 6))); a = MFMA16(kf, qf[u], a); }
                sacc[i][ct] = a; } }
        float mx = -3e38f;
#pragma unroll
        for (int i = 0; i < 4; ++i)
#pragma unroll
            for (int ct = 0; ct < 2; ++ct)
#pragma unroll
                for (int e = 0; e < 4; ++e) { const float sv = sacc[i][ct][e] * (0.125f * LOG2E) + bias[i][ct][e]; sacc[i][ct][e] = sv; mx = fmaxf(mx, sv); }
        mx = fmaxf(mx, __shfl_xor(mx, 16)); mx = fmaxf(mx, __shfl_xor(mx, 32));
        float ls = 0.f; bf16x8 pf[4];
#pragma unroll
        for (int i = 0; i < 4; ++i) { float p[8];
#pragma unroll
            for (int ct = 0; ct < 2; ++ct)
#pragma unroll
                for (int e = 0; e < 4; ++e) { p[4 * ct + e] = __builtin_amdgcn_exp2f(sacc[i][ct][e] - mx); ls += p[4 * ct + e]; }
            v4u w; w.x = pk2(p[0], p[1]); w.y = pk2(p[2], p[3]); w.z = pk2(p[4], p[5]); w.w = pk2(p[6], p[7]); pf[i] = __builtin_bit_cast(bf16x8, w); }
        ls += __shfl_xor(ls, 16); ls += __shfl_xor(ls, 32);
        hf32x4 oacc[4];
#pragma unroll
        for (int mt = 0; mt < 4; ++mt) oacc[mt] = (hf32x4){0.f, 0.f, 0.f, 0.f};
#pragma unroll
        for (int i = 0; i < 4; ++i) { const int slot = (rs + 4 * kh + i) & 7;
#pragma unroll
            for (int mt = 0; mt < 4; ++mt) {
                const s16x4 v0 = __builtin_amdgcn_ds_read_tr16_b64_v4i16((LAS s16x4*)(L + NA_V + slot * 8192 + (voff[0] ^ (mt << 5))));
                const s16x4 v1 = __builtin_amdgcn_ds_read_tr16_b64_v4i16((LAS s16x4*)(L + NA_V + slot * 8192 + (voff[1] ^ (mt << 5))));
                const bf16x8 vf = __builtin_shufflevector(v0, v1, 0, 1, 2, 3, 4, 5, 6, 7);
                oacc[mt] = MFMA16(vf, pf[i], oacc[mt]); } }
        LAS float* X = (LAS float*)(L + NA_X) + (j * 64 + lane) * 18;
        if (kh == 1) {
#pragma unroll
            for (int mt = 0; mt < 4; ++mt) { X[4 * mt + 0] = oacc[mt][0]; X[4 * mt + 1] = oacc[mt][1]; X[4 * mt + 2] = oacc[mt][2]; X[4 * mt + 3] = oacc[mt][3]; }
            X[16] = mx; X[17] = ls;
        }
        __syncthreads();
        if (do_stage) { const int slot = (r + 4) & 7; *(LAS v4u*)(L + NA_K + slot * 8192 + kst) = kreg; *(LAS v4u*)(L + NA_V + slot * 8192 + vst) = vreg; }
        if (kh == 0) {
            const float m1 = X[16], l1 = X[17]; const float mm = fmaxf(mx, m1);
            const float a0 = __builtin_amdgcn_exp2f(mx - mm), a1 = __builtin_amdgcn_exp2f(m1 - mm);
            const float inv = 1.f / (a0 * ls + a1 * l1);
            const float c0 = a0 * inv, c1 = a1 * inv;
#pragma unroll
            for (int mt = 0; mt < 4; ++mt) {
                float o[4];
#pragma unroll
                for (int e = 0; e < 4; ++e) o[e] = c0 * oacc[mt][e] + c1 * X[4 * mt + e];
                const float g0 = __uint_as_float(gate[mt].x << 16), g1 = __uint_as_float(gate[mt].x & 0xffff0000u), g2 = __uint_as_float(gate[mt].y << 16), g3 = __uint_as_float(gate[mt].y & 0xffff0000u);
                o[0] *= g0 * sigmoidf_(g0); o[1] *= g1 * sigmoidf_(g1); o[2] *= g2 * sigmoidf_(g2); o[3] *= g3 * sigmoidf_(g3);
                v2u w; w.x = pk2(o[0], o[1]); w.y = pk2(o[2], o[3]);
                *(v2u*)(F.Y() + tokq * MIXW + 1024 + h * 64 + 16 * mt + 4 * g) = w; }
        }
        if (r + 1 < 32) { qf[0] = qn[0]; qf[1] = qn[1]; }
        __syncthreads();
    }
}
__device__ __forceinline__ void phase_mix(Ctx& F, int l) {
    unsigned* ctl = (unsigned*)(F.wsp() + WS_CTL);
    volatile LAS unsigned* flag = (volatile LAS unsigned*)(F.lds + LDS_FLAG);
    for (int w = blockIdx.x; w < 256; w += gridDim.x) {
        if (w < 128) {
            const int u = w;
            hgrn_unit(F, l, u);
            asm volatile("s_waitcnt vmcnt(0)" ::: "memory");
            __syncthreads();
            if (F.tid == 0) {
                __builtin_amdgcn_fence(__ATOMIC_RELEASE, "agent");
                asm volatile("s_waitcnt vmcnt(0)" ::: "memory");
                const unsigned old = __hip_atomic_fetch_add(ctl + CW_HG + (l * 64 + (u >> 1)) * 64, 1u, __ATOMIC_RELAXED, __HIP_MEMORY_SCOPE_AGENT);
                if (old == 1u) { __builtin_amdgcn_fence(__ATOMIC_ACQUIRE, "agent"); asm volatile("s_waitcnt vmcnt(0)" ::: "memory"); }
                flag[0] = old;
            }
            __syncthreads();
            const bool last = flag[0] == 1u;
            __syncthreads();
            if (last) hgrn_finalize(F, l, u >> 1);
        } else {
            na_unit(F, l, w - 128);
        }
        __syncthreads();
    }
}

__global__ void __launch_bounds__(512, 2) fwd_kernel(Args a) {
    extern __shared__ __attribute__((aligned(16))) unsigned char lds[];
    Ctx F;
    F.lds = (LAS unsigned char*)lds; F.tid = threadIdx.x; F.lane = F.tid & 63; F.wave = __builtin_amdgcn_readfirstlane(F.tid >> 6);
    F.a = &a;
    if (threadIdx.x < 4) ((LAS unsigned*)(lds + LDS_FLAG + 16))[threadIdx.x] = 0u;
    __syncthreads();
    F.bar.bar = nullptr; F.bar.x = 0; F.bar.st = nullptr;
#if defined(PROBE_PH)
    int probe_left = PROBE_REPS;
#endif
    for (int ph = a.ph_lo; ph < a.ph_hi; ++ph) {
        { int t_ = threadIdx.x; asm volatile("" : "+v"(t_)); F.tid = t_; F.lane = t_ & 63; F.wave = __builtin_amdgcn_readfirstlane(t_ >> 6); }
        if (ph == 0) phase_prologue(F);
        else if (ph == 1) phase_ln0(F);
        else {
            const int l = (ph - 2) >> 2, k = (ph - 2) & 3;
            if (k == 0) {
                pg8::Gemm g{F.H(), F.wt_in() + (size_t)l * INC * DM, MTOK, INC, DM}; pg8::StaticOrder S; S.init(MTOK, INC, gridDim.x, (int)blockIdx.x);
                pg8::EpiBf16<0> E{F.P(), INC, nullptr, 0, 0, 1.f};
                pg8::gemm_phase<pg8::EpiBf16<0>, pg8::StaticOrder, true, true>(F.lds, g, S, E);
            } else if (k == 1) {
                phase_mix(F, l);
            } else if (k == 2) {
                pg8::Gemm g{F.Y(), F.wt_out() + (size_t)l * DM * MIXW, MTOK, DM, MIXW}; pg8::StaticOrder S; S.init(MTOK, DM, gridDim.x, (int)blockIdx.x);
                EpiZ E{l == 0 ? F.x() : F.out(), F.out(), F.mod() + (size_t)l * NB * ADAC + 2 * DM};
                pg8::gemm_phase<EpiZ, pg8::StaticOrder, false, true>(F.lds, g, S, E);
            } else {
                phase_ln(F, l);
            }
        }
#if defined(PROBE_PH)
        if (ph == PROBE_PH && probe_left > 0) { --probe_left; --ph; __syncthreads(); continue; }
#endif
#if defined(PROBE_SYNCS)
        if (ph == 1) { for (int q_ = 0; q_ < PROBE_SYNCS; ++q_) { xcd_barrier(F.bar); } }
#endif
        if (ph + 1 < a.ph_hi) {
            if (ph == 0) { __syncthreads(); cg::this_grid().sync(); F.bar = xcd_barrier_post((unsigned*)(a.ws + WS_CTL) + CW_BAR, (volatile LAS unsigned*)(F.lds + LDS_FLAG + 16)); }
            else xcd_barrier(F.bar);
        }
    }
}

__global__ void fill_kernel(float* o, int n, float v) { for (int i = blockIdx.x * blockDim.x + threadIdx.x; i < n; i += gridDim.x * blockDim.x) o[i] = v; }

extern "C" void kernel_launch(void* const* d_in, const int* in_sizes, int n_in, void* d_out, int out_size, void* d_ws, size_t ws_size, hipStream_t stream) {
    static int grid = 0;
    if (grid == 0) {
        int dev = 0, cus = 0;
        if (hipGetDevice(&dev) != hipSuccess || hipDeviceGetAttribute(&cus, hipDeviceAttributeMultiprocessorCount, dev) != hipSuccess) { grid = -1; return; }
        if (hipFuncSetAttribute((const void*)fwd_kernel, hipFuncAttributeMaxDynamicSharedMemorySize, LDS_BYTES) != hipSuccess) { grid = -1; return; }
        int per_cu = 0;
        if (hipOccupancyMaxActiveBlocksPerMultiprocessor(&per_cu, (const void*)fwd_kernel, 512, LDS_BYTES) != hipSuccess || per_cu < 1) { fprintf(stderr, "occupancy query: %d\n", per_cu); }
        (void)hipGetLastError();
        grid = cus * (per_cu < 1 ? 1 : (per_cu > 1 ? 1 : per_cu));
    }
    if (grid < 0) return;
    if (n_in != 11 || out_size != MTOK * DM || ws_size < WS_END) { fill_kernel<<<256, 256, 0, stream>>>((float*)d_out, out_size, ws_size < WS_END ? 12345.0f : 54321.0f); return; }
    Args a{};
    for (int i = 0; i < 11; ++i) a.in[i] = (const float*)d_in[i];
    a.out = (float*)d_out; a.ws = (unsigned char*)d_ws;
    a.ph_lo = 0; a.ph_hi = NPHASE; a.coop = 1;
    void* kargs[] = {&a};
    hipError_t e = hipLaunchCooperativeKernel((const void*)fwd_kernel, dim3(grid), dim3(512), kargs, LDS_BYTES, stream);
    if (e != hipSuccess) fprintf(stderr, "cooperative launch failed: %s (grid %d)\n", hipGetErrorString(e), grid);
}
```
